# Optimizing an MI355X kernel written in HIP

```python
import math
import jax, jax.numpy as jnp
from jax import lax
import numpy as np

D_MODEL = 1024
BATCH = 8
SEQ = 8192
DEPTH = 1
DEC_BATCH = 16
DEC_SEQ = 32
PAST_LEN = 4096

CHUNK = 64
D_MIX = 2 * D_MODEL
HA = 8
DK_A = 128
DV_A = 128
CONV_W = 4
WA = HA * DV_A
QKV_A = HA * (2 * DK_A + DV_A)
HB = 4
DQK_B = 64
DV_B = 2 * DQK_B
WB = HB * DV_B
HC = 4
DH_C = 128
WC = HC * DH_C
N_MEM = 256
Q_BLOCK = 128
EPS = 1e-6
IN_SIZES = (QKV_A, WA, HA, HA, HB * 2 * DQK_B, HB * 2 * DQK_B, WB, WB, WC, WC)
N_IN = sum(IN_SIZES)

kernel_name = 'hybrid_gdn_diffattn_mem_stream_step'


def rmsnorm(x, g):
    xf = x.astype(jnp.float32)
    y = xf * lax.rsqrt(jnp.mean(xf * xf, -1, keepdims=True) + EPS)
    return (y * g.astype(jnp.float32)).astype(x.dtype)


def l2norm(x):
    xf = x.astype(jnp.float32)
    return xf * lax.rsqrt(jnp.sum(xf * xf, -1, keepdims=True) + EPS)


def split_points():
    pts, acc = [], 0
    for s in IN_SIZES[:-1]:
        acc += s
        pts.append(acc)
    return pts


def causal_conv(x, buf, w):
    L = x.shape[1]
    xp = jnp.concatenate([buf.astype(x.dtype), x], axis=1)
    y = xp[:, 0:L] * w[0]
    for i in range(1, CONV_W):
        y = y + xp[:, i:i + L] * w[i]
    return jax.nn.silu(y), xp[:, -(CONV_W - 1):]


def gated_delta_blocks(q, k, v, g, beta, s0):
    B, L, H, DK = q.shape
    DV = v.shape[-1]
    C = min(CHUNK, L)
    N = L // C
    qc = q.reshape(B, N, C, H, DK).transpose(0, 1, 3, 2, 4)
    kc = k.reshape(B, N, C, H, DK).transpose(0, 1, 3, 2, 4)
    vc = v.reshape(B, N, C, H, DV).transpose(0, 1, 3, 2, 4)
    gc = g.reshape(B, N, C, H).transpose(0, 1, 3, 2)
    bc = beta.reshape(B, N, C, H).transpose(0, 1, 3, 2)
    G = jnp.cumsum(gc, -1)
    causal = jnp.tril(jnp.ones((C, C), bool))
    strict = jnp.tril(jnp.ones((C, C), bool), -1)
    decay = jnp.exp(jnp.where(causal, G[..., :, None] - G[..., None, :], -jnp.inf))
    kk = jnp.einsum('bnhid,bnhjd->bnhij', kc, kc)
    lmat = jnp.where(strict, bc[..., :, None] * kk * decay, 0.0)
    eye = jnp.eye(C, dtype=jnp.float32)
    rhs = jnp.concatenate([vc * bc[..., None], kc * (bc * jnp.exp(G))[..., None]], -1)
    sol = lax.linalg.triangular_solve(eye + lmat, rhs, left_side=True, lower=True,
                                      unit_diagonal=True)
    U, W = sol[..., :DV], sol[..., DV:]
    attn = jnp.einsum('bnhid,bnhjd->bnhij', qc, kc) * decay
    q_dec = qc * jnp.exp(G)[..., None]
    k_tail = kc * jnp.exp(G[..., -1:] - G)[..., None]
    g_last = jnp.exp(G[..., -1])

    def step(S, xs):
        u_n, w_n, a_n, qd_n, kt_n, gl_n = xs
        e = u_n - jnp.einsum('bhcd,bhde->bhce', w_n, S)
        o = jnp.einsum('bhcd,bhde->bhce', qd_n, S) + jnp.einsum('bhij,bhje->bhie', a_n, e)
        S = S * gl_n[..., None, None] + jnp.einsum('bhcd,bhce->bhde', kt_n, e)
        return S, o

    xs = tuple(jnp.moveaxis(t, 1, 0) for t in (U, W, attn, q_dec, k_tail, g_last))
    S, o = lax.scan(step, s0.astype(jnp.float32), xs)
    o = o.transpose(1, 0, 3, 2, 4).reshape(B, L, H, DV)
    return o, S


def diff_attn_rows(q, qpos, k, v, kpos, lam):
    s = jnp.einsum('bqhmd,bkhmd->bhmqk', q, k).astype(jnp.float32) * DQK_B ** -0.5
    mask = (kpos[None, :] // CHUNK) <= (qpos[:, None] // CHUNK)
    p = jax.nn.softmax(jnp.where(mask, s, -jnp.inf), axis=-1)
    a = p[:, :, 0] - lam * p[:, :, 1]
    return jnp.einsum('bhqk,bkhe->bqhe', a.astype(v.dtype), v)


def diff_attend(q, qpos, k, v, kpos, lam):
    B, L = q.shape[:2]
    if L > Q_BLOCK and L % Q_BLOCK == 0:
        nb = L // Q_BLOCK
        qb = jnp.moveaxis(q.reshape(B, nb, Q_BLOCK, *q.shape[2:]), 1, 0)
        pb = qpos.reshape(nb, Q_BLOCK)
        o = lax.map(lambda xs: diff_attn_rows(xs[0], xs[1], k, v, kpos, lam), (qb, pb))
        return jnp.moveaxis(o, 0, 1).reshape(B, L, *o.shape[3:])
    return diff_attn_rows(q, qpos, k, v, kpos, lam)


def mem_attend(q, mk, mv):
    s = jnp.einsum('bqhd,bmhd->bhqm', q, mk).astype(jnp.float32) * DH_C ** -0.5
    p = jax.nn.softmax(s, axis=-1)
    return jnp.einsum('bhqm,bmhd->bqhd', p.astype(mv.dtype), mv)


def hybrid_layer(x, pos, kpos, k_past, v_past, mem_k, mem_v, conv_buf, s0,
                 g_pre, w_in, conv_w, a_log, dt_bias, g_gdn, lam_vec, g_sub, w_out, lam_init):
    B, L, _ = x.shape
    h = rmsnorm(x, g_pre)
    proj = h @ w_in
    qkv_a, z_a, b_a, a_a, q_b, k_b, v_b, z_b, q_c, z_c = jnp.split(proj, split_points(), -1)
    qkv, conv_new = causal_conv(qkv_a, conv_buf, conv_w)
    qa, ka, va = jnp.split(qkv, [HA * DK_A, 2 * HA * DK_A], -1)
    qa = l2norm(qa.reshape(B, L, HA, DK_A)) * DK_A ** -0.5
    ka = l2norm(ka.reshape(B, L, HA, DK_A))
    va = va.reshape(B, L, HA, DV_A).astype(jnp.float32)
    beta = jax.nn.sigmoid(b_a.astype(jnp.float32))
    g = -jnp.exp(a_log.astype(jnp.float32)) * jax.nn.softplus(
        a_a.astype(jnp.float32) + dt_bias.astype(jnp.float32))
    o_a, s_new = gated_delta_blocks(qa, ka, va, g, beta, s0)
    o_a = rmsnorm(o_a, g_gdn) * jax.nn.silu(z_a.reshape(B, L, HA, DV_A).astype(jnp.float32))
    o_a = o_a.reshape(B, L, WA).astype(x.dtype)
    qb = q_b.reshape(B, L, HB, 2, DQK_B)
    k_new = k_b.reshape(B, L, HB, 2, DQK_B)
    v_new = v_b.reshape(B, L, HB, DV_B)
    if k_past is None:
        k_all, v_all = k_new, v_new
    else:
        k_all = jnp.concatenate([k_past.astype(k_new.dtype), k_new], axis=1)
        v_all = jnp.concatenate([v_past.astype(v_new.dtype), v_new], axis=1)
    lv = lam_vec.astype(jnp.float32)
    lam = jnp.exp(jnp.sum(lv[0] * lv[1])) - jnp.exp(jnp.sum(lv[2] * lv[3])) + lam_init
    o_b = diff_attend(qb, pos, k_all, v_all, kpos, lam)
    o_b = rmsnorm(o_b, g_sub) * (1.0 - lam_init) * jax.nn.silu(z_b.reshape(B, L, HB, DV_B))
    o_c = mem_attend(q_c.reshape(B, L, HC, DH_C), mem_k.astype(x.dtype), mem_v.astype(x.dtype))
    o_c = o_c * jax.nn.silu(z_c.reshape(B, L, HC, DH_C))
    mixed = jnp.concatenate([o_a, o_b.reshape(B, L, WB).astype(x.dtype),
                             o_c.reshape(B, L, WC).astype(x.dtype)], -1)
    y = x + mixed @ w_out
    return y, k_new, v_new, conv_new, s_new.astype(s0.dtype)


def setup_inputs(seed: int = 0) -> dict:
    key = jax.random.key(seed)
    ks = jax.random.split(key, 24)
    f = jnp.float32

    def nrm(k, shape, s):
        return jax.random.normal(k, shape, f) * s

    dt = jnp.exp(jax.random.uniform(ks[13], (DEPTH, HA), f, math.log(1e-3), math.log(1e-1)))
    return {
        'x_prompt': nrm(ks[0], (BATCH, SEQ, D_MODEL), 1.0),
        'x_sample': nrm(ks[1], (DEC_BATCH, DEC_SEQ, D_MODEL), 1.0),
        'mem_prompt': nrm(ks[2], (BATCH, N_MEM, D_MODEL), 1.0),
        'cache_diff_k': nrm(ks[3], (DEPTH, DEC_BATCH, PAST_LEN, HB, 2, DQK_B), 1.0),
        'cache_diff_v': nrm(ks[4], (DEPTH, DEC_BATCH, PAST_LEN, HB, DV_B), 1.0),
        'cache_mem_k': nrm(ks[5], (DEPTH, DEC_BATCH, N_MEM, HC, DH_C), 1.0),
        'cache_mem_v': nrm(ks[6], (DEPTH, DEC_BATCH, N_MEM, HC, DH_C), 1.0),
        'state_gdn': nrm(ks[7], (DEPTH, DEC_BATCH, HA, DK_A, DV_A), 0.1),
        'cache_conv': nrm(ks[8], (DEPTH, DEC_BATCH, CONV_W - 1, QKV_A), 1.0),
        'g_pre': 1.0 + nrm(ks[9], (DEPTH, D_MODEL), 0.02),
        'w_in': nrm(ks[10], (DEPTH, D_MODEL, N_IN), D_MODEL ** -0.5),
        'conv_w': nrm(ks[11], (DEPTH, CONV_W, QKV_A), CONV_W ** -0.5),
        'a_log': jnp.log(jax.random.uniform(ks[12], (DEPTH, HA), f, 1.0, 16.0)),
        'dt_bias': dt + jnp.log(-jnp.expm1(-dt)),
        'g_gdn': 1.0 + nrm(ks[14], (DEPTH, DV_A), 0.02),
        'lam_vec': nrm(ks[15], (DEPTH, 4, DQK_B), 0.1),
        'g_sub': 1.0 + nrm(ks[16], (DEPTH, DV_B), 0.02),
        'g_mem': 1.0 + nrm(ks[17], (DEPTH, D_MODEL), 0.02),
        'w_mem_kv': nrm(ks[18], (DEPTH, D_MODEL, 2 * WC), D_MODEL ** -0.5),
        'w_out': nrm(ks[19], (DEPTH, D_MIX, D_MODEL), D_MIX ** -0.5),
        'g_final': 1.0 + nrm(ks[20], (D_MODEL,), 0.02),
    }


def reference(x_prompt, x_sample, mem_prompt, cache_diff_k, cache_diff_v, cache_mem_k,
              cache_mem_v, state_gdn, cache_conv, g_pre, w_in, conv_w, a_log, dt_bias, g_gdn,
              lam_vec, g_sub, g_mem, w_mem_kv, w_out, g_final):
    B, L = x_prompt.shape[:2]
    Ls = x_sample.shape[1]
    past = cache_diff_k.shape[2]
    pos_p = jnp.arange(L, dtype=jnp.int32)
    pos_s = past + jnp.arange(Ls, dtype=jnp.int32)
    kpos_s = jnp.arange(past + Ls, dtype=jnp.int32)
    hp, hs = x_prompt, x_sample
    kp_l, vp_l, mk_l, mv_l, sp_l, cp_l = [], [], [], [], [], []
    ks_l, vs_l, ss_l, cs_l = [], [], [], []
    for i in range(DEPTH):
        lam_init = 0.8 - 0.6 * math.exp(-0.3 * i)
        wts = (g_pre[i], w_in[i], conv_w[i], a_log[i], dt_bias[i], g_gdn[i], lam_vec[i],
               g_sub[i], w_out[i], lam_init)
        mem_n = rmsnorm(mem_prompt, g_mem[i])
        mk, mv = jnp.split(mem_n @ w_mem_kv[i], 2, -1)
        mk = mk.reshape(B, N_MEM, HC, DH_C)
        mv = mv.reshape(B, N_MEM, HC, DH_C)
        conv0 = jnp.zeros((B, CONV_W - 1, QKV_A), x_prompt.dtype)
        s0 = jnp.zeros((B, HA, DK_A, DV_A), x_prompt.dtype)
        hp, kp, vp, cp, sp = hybrid_layer(hp, pos_p, pos_p, None, None, mk, mv, conv0, s0, *wts)
        hs, kn, vn, cn, sn = hybrid_layer(hs, pos_s, kpos_s, cache_diff_k[i], cache_diff_v[i],
                                          cache_mem_k[i], cache_mem_v[i], cache_conv[i],
                                          state_gdn[i], *wts)
        kp_l.append(kp); vp_l.append(vp); mk_l.append(mk); mv_l.append(mv)
        sp_l.append(sp); cp_l.append(cp)
        ks_l.append(kn); vs_l.append(vn); ss_l.append(sn); cs_l.append(cn)
    y_prompt = rmsnorm(hp, g_final)
    y_sample = rmsnorm(hs, g_final)
    return (y_prompt, y_sample, jnp.stack(kp_l), jnp.stack(vp_l), jnp.stack(mk_l),
            jnp.stack(mv_l), jnp.stack(sp_l), jnp.stack(cp_l), jnp.stack(ks_l),
            jnp.stack(vs_l), jnp.stack(ss_l), jnp.stack(cs_l))
```

```cpp
#include <hip/hip_runtime.h>
#include <hip/hip_cooperative_groups.h>
#include <cstdio>
#include <cstdint>
namespace cg = cooperative_groups;

#ifndef ONE_LAUNCH
#define ONE_LAUNCH 1
#endif

typedef __attribute__((ext_vector_type(8))) short bf16x8;
typedef __attribute__((ext_vector_type(4))) short s16x4;
typedef __attribute__((ext_vector_type(16))) float f32x16;
typedef __attribute__((ext_vector_type(2))) __bf16 bf2_t;
typedef unsigned short u16;
typedef __attribute__((ext_vector_type(4))) unsigned u32x4;
typedef __attribute__((ext_vector_type(2))) unsigned u32x2;
#define DI __device__ __forceinline__
#define MFMA(a, b, c) __builtin_amdgcn_mfma_f32_32x32x16_bf16((a), (b), (c), 0, 0, 0)

constexpr int NP = 65536;
constexpr int NS = 512;
constexpr int NT = NP + NS;
constexpr float EPSF = 1e-6f;

constexpr size_t SZ_QKV = (size_t)NT * 3072 * 2;
constexpr size_t SZ_1024 = (size_t)NT * 1024 * 2;
constexpr size_t SZ_512 = (size_t)NT * 512 * 2;
constexpr size_t OFF_QKV = 0;
constexpr size_t OFF_ZA = OFF_QKV + SZ_QKV;
constexpr size_t OFF_QB = OFF_ZA + SZ_1024;
constexpr size_t OFF_KB = OFF_QB + SZ_512;
constexpr size_t OFF_ZB = OFF_KB + SZ_512;
constexpr size_t OFF_QC = OFF_ZB + SZ_512;
constexpr size_t OFF_ZC = OFF_QC + SZ_512;
constexpr size_t OFF_VBT = OFF_ZC + SZ_512;
constexpr size_t VBT_S_EL = (size_t)8 * 4 * 128 * 8192;
constexpr size_t OFF_WINT = OFF_VBT + SZ_512;
constexpr size_t OFF_WOUTT = OFF_WINT + (size_t)7168 * 1024 * 2;
constexpr size_t OFF_WMEMT = OFF_WOUTT + (size_t)1024 * 2048 * 2;
constexpr size_t OFF_MEMN = OFF_WMEMT + (size_t)1024 * 1024 * 2;
constexpr size_t OFF_MEMK = OFF_MEMN + (size_t)2048 * 1024 * 2;
constexpr size_t OFF_MEMVT = OFF_MEMK + (size_t)2048 * 512 * 2;
constexpr size_t OFF_BA = OFF_MEMVT + (size_t)2048 * 512 * 2;
constexpr size_t OFF_GL = OFF_BA + (size_t)NT * 16 * 4;
constexpr size_t OFF_CTR = OFF_GL + (size_t)8320 * 4;
constexpr size_t WS_NEED = OFF_CTR + 8192;
constexpr size_t YO_H = 0;
constexpr size_t YO_W = 0;
constexpr size_t YO_HALO = (size_t)8320 * 8192 * 2;
constexpr size_t YO_ATT = YO_HALO + (size_t)8 * 128 * 3 * 3072 * 2;
constexpr size_t O_YP = 0;
constexpr size_t O_YS = O_YP + (size_t)NP * 1024;
constexpr size_t O_KP = O_YS + (size_t)NS * 1024;
constexpr size_t O_VP = O_KP + (size_t)NP * 512;
constexpr size_t O_MK = O_VP + (size_t)NP * 512;
constexpr size_t O_MV = O_MK + (size_t)2048 * 512;
constexpr size_t O_SP = O_MV + (size_t)2048 * 512;
constexpr size_t O_CP = O_SP + (size_t)8 * 8 * 128 * 128;
constexpr size_t O_KS = O_CP + (size_t)8 * 3 * 3072;
constexpr size_t O_VS = O_KS + (size_t)NS * 512;
constexpr size_t O_SS = O_VS + (size_t)NS * 512;
constexpr size_t O_CS = O_SS + (size_t)16 * 8 * 128 * 128;

struct Params {
  const float *x_prompt, *x_sample, *mem_prompt, *cache_diff_k, *cache_diff_v, *cache_mem_k, *cache_mem_v, *state_gdn, *cache_conv;
  const float *g_pre, *w_in, *conv_w, *a_log, *dt_bias, *g_gdn, *lam_vec, *g_sub, *g_mem, *w_mem_kv, *w_out, *g_final;
  float* out;
  char* ws;
};

__shared__ __attribute__((aligned(16))) char smem[79872];

DI unsigned pk2(float a, float b) { bf2_t v; v[0] = (__bf16)a; v[1] = (__bf16)b; return __builtin_bit_cast(unsigned, v); }
DI u16 f2bf(float a) { return __builtin_bit_cast(u16, (__bf16)a); }
DI float bf2f(u16 v) { return __uint_as_float(((unsigned)v) << 16); }
DI float bflo(unsigned v) { return __uint_as_float(v << 16); }
DI float bfhi(unsigned v) { return __uint_as_float(v & 0xffff0000u); }
DI int otid() { int t = threadIdx.x; asm volatile("" : "+v"(t)); return t; }
DI void st16_wt(void* ptr, uint4 v) { u32x4 d = {v.x, v.y, v.z, v.w}; asm volatile("global_store_dwordx4 %0, %1, off sc1\n\ts_nop 1" :: "v"(ptr), "v"(d) : "memory"); }
DI void st2_wt(void* ptr, u16 v) { unsigned d = v; asm volatile("global_store_short %0, %1, off sc1\n\ts_nop 1" :: "v"(ptr), "v"(d) : "memory"); }
DI int swap23(int k) { return (k & ~12) | ((k & 4) << 1) | ((k & 8) >> 1); }
DI int crow(int reg, int h) { return (reg & 3) + 8 * (reg >> 2) + 4 * h; }
DI float wave_sum(float v) { for (int o = 32; o > 0; o >>= 1) v += __shfl_xor(v, o); return v; }
DI float silu(float z) { return z * __builtin_amdgcn_rcpf(1.f + __expf(-z)); }
DI bf16x8 pack8(const f32x16& x, int t) {
  uint4 p; p.x = pk2(x[8 * t], x[8 * t + 1]); p.y = pk2(x[8 * t + 2], x[8 * t + 3]); p.z = pk2(x[8 * t + 4], x[8 * t + 5]); p.w = pk2(x[8 * t + 6], x[8 * t + 7]);
  return __builtin_bit_cast(bf16x8, p);
}
DI bf16x8 ld_a2(const u16* p) {
  s16x4 lo = *(const s16x4*)p; s16x4 hi = *(const s16x4*)(p + 8);
  return __builtin_shufflevector(lo, hi, 0, 1, 2, 3, 4, 5, 6, 7);
}
DI f32x16 zero16() { f32x16 z; _Pragma("unroll") for (int i = 0; i < 16; ++i) z[i] = 0.f; return z; }

DI void p0_transpose_tile(const float* src, int ld_src, int k0, int srccol0, u16* dst, int ld_dst, int n0) {
  float* t = (float*)smem;
  const int tid = otid(), r = tid >> 6, c = tid & 63;
  for (int i = 0; i < 16; ++i) { int row = r + 4 * i; t[row * 65 + c] = src[(size_t)(k0 + row) * ld_src + srccol0 + c]; }
  __syncthreads();
  for (int i = 0; i < 16; ++i) { int n = r + 4 * i; dst[(size_t)(n0 + n) * ld_dst + k0 + c] = f2bf(t[c * 65 + n]); }
  __syncthreads();
}

DI void phase0(const Params& p) {
  const int tid = otid();
  u16* WinT = (u16*)(p.ws + OFF_WINT); u16* WoutT = (u16*)(p.ws + OFF_WOUTT); u16* WmemT = (u16*)(p.ws + OFF_WMEMT);
  for (int t = blockIdx.x; t < 2560; t += gridDim.x) {
    if (t < 1792) { int kt = t / 112, nt = t % 112; int n0 = nt * 64; int sc = n0 < 4096 ? n0 : n0 + 16; p0_transpose_tile(p.w_in, 7184, kt * 64, sc, WinT, 1024, n0); }
    else if (t < 2304) { int u = t - 1792; int kt = u / 16, nt = u % 16; p0_transpose_tile(p.w_out, 1024, kt * 64, nt * 64, WoutT, 2048, nt * 64); }
    else { int u = t - 2304; int kt = u / 16, nt = u % 16; p0_transpose_tile(p.w_mem_kv, 1024, kt * 64, nt * 64, WmemT, 1024, nt * 64); }
  }
  float* wab = (float*)smem;
  __syncthreads();
  for (int i = 0; i < 64; ++i) { int idx = tid + 256 * i; int k = idx >> 4, j = idx & 15; wab[j * 1024 + k] = p.w_in[(size_t)k * 7184 + 4096 + j]; }
  __syncthreads();
  const int w = tid >> 6, lane = tid & 63;
  u16* H = (u16*)((char*)p.out + YO_H); u16* MEMN = (u16*)(p.ws + OFF_MEMN); float* BA = (float*)(p.ws + OFF_BA);
  for (int row = blockIdx.x * 4 + w; row < NT + 2048; row += gridDim.x * 4) {
    const float* src; const float* g; u16* dst;
    if (row < NP) { src = p.x_prompt + (size_t)row * 1024; g = p.g_pre; dst = H + (size_t)row * 1024; }
    else if (row < NT) { src = p.x_sample + (size_t)(row - NP) * 1024; g = p.g_pre; dst = H + (size_t)row * 1024; }
    else { src = p.mem_prompt + (size_t)(row - NT) * 1024; g = p.g_mem; dst = MEMN + (size_t)(row - NT) * 1024; }
    float4 xv[4]; float ss = 0.f;
#pragma unroll
    for (int i = 0; i < 4; ++i) { xv[i] = *(const float4*)(src + i * 256 + lane * 4); ss += xv[i].x * xv[i].x + xv[i].y * xv[i].y + xv[i].z * xv[i].z + xv[i].w * xv[i].w; }
    ss = wave_sum(ss);
    const float rstd = rsqrtf(ss * (1.f / 1024.f) + EPSF);
#pragma unroll
    for (int i = 0; i < 4; ++i) {
      float4 gv = *(const float4*)(g + i * 256 + lane * 4);
      xv[i].x *= rstd * gv.x; xv[i].y *= rstd * gv.y; xv[i].z *= rstd * gv.z; xv[i].w *= rstd * gv.w;
      uint2 o; o.x = pk2(xv[i].x, xv[i].y); o.y = pk2(xv[i].z, xv[i].w);
      *(uint2*)(dst + i * 256 + lane * 4) = o;
    }
    if (row < NT) {
      float v[16];
#pragma unroll
      for (int j = 0; j < 16; ++j) {
        float a = 0.f;
#pragma unroll
        for (int i = 0; i < 4; ++i) { float4 wv = *(const float4*)(wab + j * 1024 + i * 256 + lane * 4); a += xv[i].x * wv.x + xv[i].y * wv.y + xv[i].z * wv.z + xv[i].w * wv.w; }
        v[j] = a;
        if ((j & 3) == 3) asm volatile("" ::: "memory");
      }
      { const bool up = lane & 32;
        _Pragma("unroll") for (int t = 0; t < 8; ++t) { const float send = up ? v[t] : v[t + 8]; const float keep = up ? v[t + 8] : v[t]; v[t] = keep + __shfl_xor(send, 32); } }
      { const bool up = lane & 16;
        _Pragma("unroll") for (int t = 0; t < 4; ++t) { const float send = up ? v[t] : v[t + 4]; const float keep = up ? v[t + 4] : v[t]; v[t] = keep + __shfl_xor(send, 16); } }
      { const bool up = lane & 8;
        _Pragma("unroll") for (int t = 0; t < 2; ++t) { const float send = up ? v[t] : v[t + 2]; const float keep = up ? v[t + 2] : v[t]; v[t] = keep + __shfl_xor(send, 8); } }
      { const bool up = lane & 4; const float send = up ? v[0] : v[1]; const float keep = up ? v[1] : v[0]; v[0] = keep + __shfl_xor(send, 4); }
      v[0] += __shfl_xor(v[0], 2); v[0] += __shfl_xor(v[0], 1);
      if ((lane & 3) == 0) { const int j = ((lane >> 5) & 1) * 8 + ((lane >> 4) & 1) * 4 + ((lane >> 3) & 1) * 2 + ((lane >> 2) & 1); BA[(size_t)row * 16 + j] = v[0]; }
    }
  }
}

DI unsigned xcc_id() { return (unsigned)__builtin_amdgcn_s_getreg((3 << 11) | 20) & 7u; }
DI int xq_fetch(unsigned* q8, int per, unsigned xcc, int& steal) {
  while (steal < 8) {
    const unsigned x = (xcc + steal) & 7u;
    const int q = (int)atomicAdd(q8 + x, 1u);
    if (q < per) return (int)x * per + q;
    ++steal;
  }
  return -1;
}

struct GRegs { u32x4 a0, a1, a2, a3, b0, b1, b2, b3, b4, b5, b6, b7; };
DI void gemm_gload(GRegs& g, int kt, const u16* ap0, int ld0, const u16* ap1, int ld1, const u16* ap2, int ld2, int kt1, int kt2, const u16* Bt, int ldb) {
  const int tid = otid();
  const u16* ap; int lda; int kk;
  if (kt < kt1) { ap = ap0; lda = ld0; kk = kt; } else if (kt < kt2) { ap = ap1; lda = ld1; kk = kt - kt1; } else { ap = ap2; lda = ld2; kk = kt - kt2; }
  const int row = tid >> 3, ch = tid & 7;
  const u16* pa = ap + (unsigned)(row * lda + kk * 64 + ch * 8);
  const u16* pb = Bt + (unsigned)(row * ldb + kt * 64 + ch * 8);
  g.a0 = *(const u32x4*)(pa); g.a1 = *(const u32x4*)(pa + (unsigned)(32 * lda)); g.a2 = *(const u32x4*)(pa + (unsigned)(64 * lda)); g.a3 = *(const u32x4*)(pa + (unsigned)(96 * lda));
  g.b0 = *(const u32x4*)(pb); g.b1 = *(const u32x4*)(pb + (unsigned)(32 * ldb)); g.b2 = *(const u32x4*)(pb + (unsigned)(64 * ldb)); g.b3 = *(const u32x4*)(pb + (unsigned)(96 * ldb));
  g.b4 = *(const u32x4*)(pb + (unsigned)(128 * ldb)); g.b5 = *(const u32x4*)(pb + (unsigned)(160 * ldb)); g.b6 = *(const u32x4*)(pb + (unsigned)(192 * ldb)); g.b7 = *(const u32x4*)(pb + (unsigned)(224 * ldb));
}
DI void gemm_store(const GRegs& g, u16* As) {
  const int tid = otid(); const int srow = tid >> 3, sch = tid & 7;
  u16* pa = As + srow * 72 + sch * 8; u16* pb = pa + 128 * 72;
  *(u32x4*)(pa) = g.a0; *(u32x4*)(pa + 32 * 72) = g.a1; *(u32x4*)(pa + 64 * 72) = g.a2; *(u32x4*)(pa + 96 * 72) = g.a3;
  *(u32x4*)(pb) = g.b0; *(u32x4*)(pb + 32 * 72) = g.b1; *(u32x4*)(pb + 64 * 72) = g.b2; *(u32x4*)(pb + 96 * 72) = g.b3;
  *(u32x4*)(pb + 128 * 72) = g.b4; *(u32x4*)(pb + 160 * 72) = g.b5; *(u32x4*)(pb + 192 * 72) = g.b6; *(u32x4*)(pb + 224 * 72) = g.b7;
}
template <bool SWAP>
DI void gemm_core(const u16* ap0, int ld0, const u16* ap1, int ld1, const u16* ap2, int ld2, int kt1, int kt2, const u16* Bt, int ldb, int nk, f32x16 (&acc)[2][4]) {
  const int tid = otid(), w = tid >> 6, lane = tid & 63, r = lane & 31, h = lane >> 5, wm = w >> 1, wn = w & 1;
  const u16* As = (const u16*)smem; const u16* Bs = As + 128 * 72;
  GRegs g;
  gemm_gload(g, 0, ap0, ld0, ap1, ld1, ap2, ld2, kt1, kt2, Bt, ldb);
  __syncthreads();
  gemm_store(g, (u16*)smem);
  __syncthreads();
  for (int kt = 0; kt < nk; ++kt) {
    if (kt + 1 < nk) gemm_gload(g, kt + 1, ap0, ld0, ap1, ld1, ap2, ld2, kt1, kt2, Bt, ldb);
#pragma unroll
    for (int ks = 0; ks < 4; ++ks) {
      bf16x8 a0 = *(const bf16x8*)(As + (wm * 64 + r) * 72 + ks * 16 + h * 8);
      bf16x8 a1 = *(const bf16x8*)(As + (wm * 64 + 32 + r) * 72 + ks * 16 + h * 8);
#pragma unroll
      for (int ct = 0; ct < 4; ++ct) {
        bf16x8 b = *(const bf16x8*)(Bs + (wn * 128 + ct * 32 + r) * 72 + ks * 16 + h * 8);
        if (SWAP) { acc[0][ct] = MFMA(b, a0, acc[0][ct]); acc[1][ct] = MFMA(b, a1, acc[1][ct]); }
        else { acc[0][ct] = MFMA(a0, b, acc[0][ct]); acc[1][ct] = MFMA(a1, b, acc[1][ct]); }
      }
    }
    __syncthreads();
    if (kt + 1 < nk) { gemm_store(g, (u16*)smem); __syncthreads(); }
  }
}

DI void phase1(const Params& p) {
  const int tid = otid(), w = tid >> 6, lane = tid & 63, r = lane & 31, h = lane >> 5, wm = w >> 1, wn = w & 1;
  const u16* H = (const u16*)((const char*)p.out + YO_H);
  const u16* WinT = (const u16*)(p.ws + OFF_WINT); const u16* WmemT = (const u16*)(p.ws + OFF_WMEMT); const u16* MEMN = (const u16*)(p.ws + OFF_MEMN);
  u16* QKV = (u16*)(p.ws + OFF_QKV); u16* ZA = (u16*)(p.ws + OFF_ZA); u16* QB = (u16*)(p.ws + OFF_QB); u16* KB = (u16*)(p.ws + OFF_KB);
  u16* ZB = (u16*)(p.ws + OFF_ZB); u16* QC = (u16*)(p.ws + OFF_QC); u16* ZC = (u16*)(p.ws + OFF_ZC); u16* VBT = (u16*)(p.ws + OFF_VBT);
  u16* MEMK = (u16*)(p.ws + OFF_MEMK); u16* MEMVT = (u16*)(p.ws + OFF_MEMVT);
  u16* HALO = (u16*)((char*)p.out + YO_HALO);
  __shared__ int s_t1;
  int steal1 = 0; const unsigned xcc1 = xcc_id();
  while (true) {
    __syncthreads();
    if (otid() == 0) {
      int code = -1;
      while (steal1 < 8) {
        const unsigned x = (xcc1 + steal1) & 7u;
        const int per = 516 * (x < 4 ? 4 : 3) + 8;
        const int q = (int)atomicAdd((unsigned*)(p.ws + OFF_CTR) + 16 + x, 1u);
        if (q < per) { code = (int)x * 4096 + q; break; }
        ++steal1;
      }
      s_t1 = code;
    }
    __syncthreads();
    const int tq = __builtin_amdgcn_readfirstlane(s_t1);
    if (tq < 0) break;
    const int xq = tq >> 12, jq = tq & 4095;
    const int nown = xq < 4 ? 4 : 3, ngemm = 516 * nown;
    const int t = jq < ngemm ? 0 : 516 * 28 + xq * 8 + (jq - ngemm);
    f32x16 acc[2][4];
#pragma unroll
    for (int a = 0; a < 2; ++a)
#pragma unroll
      for (int b = 0; b < 4; ++b) acc[a][b] = zero16();
    if (t < 516 * 28) {
      const int mt = jq / nown, nt = xq + 8 * (jq % nown), m0 = mt * 128, n0 = nt * 256;
      const u16* a0 = H + (size_t)m0 * 1024;
      int grp; int cb;
      if (n0 < 3072) { grp = 0; cb = n0; } else if (n0 < 4096) { grp = 1; cb = n0 - 3072; } else { grp = 2 + (n0 - 4096) / 512; cb = (n0 - 4096) % 512; }
      const bool samp = m0 >= NP;
      if (grp == 4) {
        gemm_core<false>(a0, 1024, a0, 1024, a0, 1024, 1000, 1000, WinT + (size_t)n0 * 1024, 1024, 16, acc);
#pragma unroll
        for (int rt = 0; rt < 2; ++rt)
#pragma unroll
          for (int ct = 0; ct < 4; ++ct) {
            const int col = cb + wn * 128 + ct * 32 + r;
            const int rowb = m0 + wm * 64 + rt * 32 + 4 * h;
            const int hh = col >> 7, dv = col & 127;
#pragma unroll
            for (int q = 0; q < 4; ++q) {
              const int row = rowb + 8 * q;
              float v0 = acc[rt][ct][4 * q], v1 = acc[rt][ct][4 * q + 1], v2 = acc[rt][ct][4 * q + 2], v3 = acc[rt][ct][4 * q + 3];
              uint2 pk; pk.x = pk2(v0, v1); pk.y = pk2(v2, v3);
              if (!samp) {
                float* o = (p.out + O_VP) + (unsigned)(row * 512 + col); o[0] = v0; o[512] = v1; o[1024] = v2; o[1536] = v3;
                const int b = row >> 13, tt = row & 8191;
                *(uint2*)(VBT + (unsigned)(((b * 4 + hh) * 128 + dv) * 8192 + swap23(tt))) = pk;
              } else {
                const int rs = row - NP; float* o = (p.out + O_VS) + (unsigned)(rs * 512 + col); o[0] = v0; o[512] = v1; o[1024] = v2; o[1536] = v3;
                const int b = rs >> 5, tt = rs & 31;
                *(uint2*)((VBT + VBT_S_EL) + (unsigned)(((b * 4 + hh) * 128 + dv) * 32 + swap23(tt))) = pk;
              }
            }
          }
      } else {
        gemm_core<true>(a0, 1024, a0, 1024, a0, 1024, 1000, 1000, WinT + (size_t)n0 * 1024, 1024, 16, acc);
        u16* dst; unsigned ldd;
        switch (grp) {
          case 0: dst = QKV; ldd = 3072; break;
          case 1: dst = ZA; ldd = 1024; break;
          case 2: dst = QB; ldd = 512; break;
          case 3: dst = KB; ldd = 512; break;
          case 5: dst = ZB; ldd = 512; break;
          case 6: dst = QC; ldd = 512; break;
          default: dst = ZC; ldd = 512; break;
        }
#pragma unroll
        for (int rt = 0; rt < 2; ++rt) {
          const int row = m0 + wm * 64 + rt * 32 + r;
          int halo_row = -1, conv_row = -1;
          if (grp == 0) {
            if (!samp) {
              const int b = row >> 13, tt = row & 8191, tm = tt & 63;
              if (tm >= 61) halo_row = (b * 128 + (tt >> 6)) * 3 + tm - 61;
              if (tt >= 8189) conv_row = b * 3 + tt - 8189;
            } else {
              const int rs = row - NP, b = rs >> 5, ts = rs & 31;
              if (ts >= 29) conv_row = b * 3 + ts - 29;
            }
          }
          float* convp = p.out + (samp ? O_CS : O_CP);
          float* kout = samp ? (p.out + O_KS) + (unsigned)((row - NP) * 512) : (p.out + O_KP) + (unsigned)(row * 512);
#pragma unroll
          for (int ct = 0; ct < 4; ++ct)
#pragma unroll
            for (int q = 0; q < 4; ++q) {
              const int col = cb + wn * 128 + ct * 32 + 8 * q + 4 * h;
              const float v0 = acc[rt][ct][4 * q], v1 = acc[rt][ct][4 * q + 1], v2 = acc[rt][ct][4 * q + 2], v3 = acc[rt][ct][4 * q + 3];
              const uint2 pk = make_uint2(pk2(v0, v1), pk2(v2, v3));
              *(uint2*)(dst + (unsigned)row * ldd + col) = pk;
              if (grp == 0) {
                if (halo_row >= 0) *(uint2*)(HALO + (unsigned)(halo_row * 3072 + col)) = pk;
                if (conv_row >= 0) *(float4*)(convp + (unsigned)(conv_row * 3072 + col)) = make_float4(v0, v1, v2, v3);
              } else if (grp == 3) {
                *(float4*)(kout + col) = make_float4(v0, v1, v2, v3);
              }
            }
        }
      }
    } else {
      const int u = t - 516 * 28, mt = u / 4, nt = u % 4, m0 = mt * 128, n0 = nt * 256;
      const u16* a0 = MEMN + (size_t)m0 * 1024;
      if (n0 < 512) {
        gemm_core<true>(a0, 1024, a0, 1024, a0, 1024, 1000, 1000, WmemT + (size_t)n0 * 1024, 1024, 16, acc);
#pragma unroll
        for (int rt = 0; rt < 2; ++rt) {
          const int row = m0 + wm * 64 + rt * 32 + r;
#pragma unroll
          for (int ct = 0; ct < 4; ++ct)
#pragma unroll
            for (int q = 0; q < 4; ++q) {
              const int col = n0 + wn * 128 + ct * 32 + 8 * q + 4 * h;
              const float v0 = acc[rt][ct][4 * q], v1 = acc[rt][ct][4 * q + 1], v2 = acc[rt][ct][4 * q + 2], v3 = acc[rt][ct][4 * q + 3];
              *(float4*)((p.out + O_MK) + (unsigned)(row * 512 + col)) = make_float4(v0, v1, v2, v3);
              *(uint2*)(MEMK + (unsigned)(row * 512 + col)) = make_uint2(pk2(v0, v1), pk2(v2, v3));
            }
        }
      } else {
        gemm_core<false>(a0, 1024, a0, 1024, a0, 1024, 1000, 1000, WmemT + (size_t)n0 * 1024, 1024, 16, acc);
#pragma unroll
        for (int rt = 0; rt < 2; ++rt)
#pragma unroll
          for (int ct = 0; ct < 4; ++ct) {
            const int col = n0 + wn * 128 + ct * 32 + r;
            const int rowb = m0 + wm * 64 + rt * 32 + 4 * h;
            const int c2 = col - 512, hh = c2 >> 7, dv = c2 & 127;
#pragma unroll
            for (int q = 0; q < 4; ++q) {
              const int row = rowb + 8 * q;
              float v0 = acc[rt][ct][4 * q], v1 = acc[rt][ct][4 * q + 1], v2 = acc[rt][ct][4 * q + 2], v3 = acc[rt][ct][4 * q + 3];
              float* o = (p.out + O_MV) + (unsigned)(row * 512 + c2); o[0] = v0; o[512] = v1; o[1024] = v2; o[1536] = v3;
              uint2 pk; pk.x = pk2(v0, v1); pk.y = pk2(v2, v3);
              const int b = row >> 8, key = row & 255;
              *(uint2*)(MEMVT + (unsigned)(((b * 4 + hh) * 128 + dv) * 256 + swap23(key))) = pk;
            }
          }
      }
    }
  }
}

constexpr int KS_LD = 136, VT_LD = 72;

DI void stage_bf16(const u16* Kp, unsigned ldk, const u16* VTp, unsigned ldv, int nkeys) {
  u16* Ks = (u16*)smem; u16* Vt = Ks + 64 * KS_LD;
  const int tid = otid();
#pragma unroll
  for (int i = 0; i < 4; ++i) { int c = tid + 256 * i, row = c >> 4, ch = c & 15; if (row < nkeys) *(uint4*)(Ks + row * KS_LD + ch * 8) = *(const uint4*)(Kp + row * ldk + ch * 8); }
  for (int i = 0; i < 4; ++i) {
    int c = tid + 256 * i, row = c >> 3, ch = c & 7;
    if (ch * 8 < nkeys) *(uint4*)(Vt + row * VT_LD + ch * 8) = *(const uint4*)(VTp + row * ldv + ch * 8);
  }
}
DI void stage_f32(const float* Kp, unsigned ldk, const float* Vp, unsigned ldv) {
  u16* Ks = (u16*)smem; u16* Vt = Ks + 64 * KS_LD;
  const int tid = otid();
  for (int i = 0; i < 8; ++i) {
    int c = tid + 256 * i, row = c >> 5, ch = c & 31;
    float4 v = *(const float4*)(Kp + row * ldk + ch * 4);
    *(uint2*)(Ks + row * KS_LD + ch * 4) = make_uint2(pk2(v.x, v.y), pk2(v.z, v.w));
  }
  for (int i = 0; i < 4; ++i) {
    int u = tid + 256 * i; int q = (u & 7) + 8 * ((u >> 6) & 3), pp = ((u >> 3) & 7) + 8 * (u >> 8);
    float4 v0 = *(const float4*)(Vp + (unsigned)(2 * pp) * ldv + q * 4);
    float4 v1 = *(const float4*)(Vp + (unsigned)(2 * pp + 1) * ldv + q * 4);
    *(unsigned*)(Vt + (q * 4 + 0) * VT_LD + swap23(2 * pp)) = pk2(v0.x, v1.x);
    *(unsigned*)(Vt + (q * 4 + 1) * VT_LD + swap23(2 * pp)) = pk2(v0.y, v1.y);
    *(unsigned*)(Vt + (q * 4 + 2) * VT_LD + swap23(2 * pp)) = pk2(v0.z, v1.z);
    *(unsigned*)(Vt + (q * 4 + 3) * VT_LD + swap23(2 * pp)) = pk2(v0.w, v1.w);
  }
}

template <int NM, int KS, int NKT>
struct AttnSt { f32x16 O[NM][4]; float m[NM], l[NM]; bf16x8 qf[NM][KS]; };

template <int NM, int KS, int NKT>
DI void attn_init(AttnSt<NM, KS, NKT>& st, const u16* qrow  , int h, bool loadq = true) {
#pragma unroll
  for (int mm = 0; mm < NM; ++mm) {
#pragma unroll
    for (int d = 0; d < 4; ++d) st.O[mm][d] = zero16();
    st.m[mm] = -1e30f; st.l[mm] = 0.f;
#pragma unroll
    for (int ks = 0; ks < KS; ++ks) if (loadq) st.qf[mm][ks] = *(const bf16x8*)(qrow + mm * 64 + ks * 16 + h * 8);
  }
}

template <int NM, int KS, int NKT>
DI void attn_step(AttnSt<NM, KS, NKT>& st, const u16* Ks, int half, int dbase, float sc  ) {
  const u16* Vt = Ks + 64 * KS_LD;
  const int lane = otid() & 63, r = lane & 31, h = lane >> 5;
#pragma unroll
  for (int mm = 0; mm < NM; ++mm) {
    f32x16 s[NKT];
#pragma unroll
    for (int T = 0; T < NKT; ++T) {
      const int k0 = (NKT == 2 ? T : half) * 32;
      s[T] = zero16();
#pragma unroll
      for (int ks = 0; ks < KS; ++ks) {
        bf16x8 a = *(const bf16x8*)(Ks + (k0 + r) * KS_LD + dbase + mm * 64 + ks * 16 + h * 8);
        s[T] = MFMA(a, st.qf[mm][ks], s[T]);
      }
    }
    float mx = -1e30f;
#pragma unroll
    for (int T = 0; T < NKT; ++T)
#pragma unroll
      for (int i = 0; i < 16; ++i) mx = fmaxf(mx, s[T][i]);
    mx = fmaxf(mx, __shfl_xor(mx, 32));
    const float mxs = mx * sc;
    if (__builtin_amdgcn_ballot_w64(mxs > st.m[mm] + 8.f) != 0) {
      const float mnew = fmaxf(st.m[mm], mxs);
      const float alpha = __builtin_amdgcn_exp2f(st.m[mm] - mnew);
      st.m[mm] = mnew;
      st.l[mm] *= alpha;
#pragma unroll
      for (int d = 0; d < 4; ++d)
#pragma unroll
        for (int i = 0; i < 16; ++i) st.O[mm][d][i] *= alpha;
    }
    const float mref = st.m[mm];
    float rs = 0.f;
#pragma unroll
    for (int T = 0; T < NKT; ++T)
#pragma unroll
      for (int i = 0; i < 16; ++i) { float pv = __builtin_amdgcn_exp2f(s[T][i] * sc - mref); s[T][i] = pv; rs += pv; }
    st.l[mm] += rs;
#pragma unroll
    for (int T = 0; T < NKT; ++T) {
      const int k0 = (NKT == 2 ? T : half) * 32;
#pragma unroll
      for (int t = 0; t < 2; ++t) {
        if (NM > 1) asm volatile("" ::: "memory");
        bf16x8 pb = pack8(s[T], t);
#pragma unroll
        for (int d = 0; d < 4; ++d) {
          bf16x8 a = *(const bf16x8*)(Vt + (d * 32 + r) * VT_LD + k0 + 16 * t + 8 * h);
          st.O[mm][d] = MFMA(a, pb, st.O[mm][d]);
        }
      }
    }
  }
}

struct KVRegs { u32x4 k0, k1, k2, k3, v0, v1, v2, v3; };
DI void kv_load(KVRegs& g, const u16* Kp, unsigned ldk, const u16* VTp, unsigned ldv) {
  const int tid = otid();
  const int krow = tid >> 4, kch = tid & 15, vrow = tid >> 3, vch = tid & 7;
  const u16* pk = Kp + (unsigned)(krow * ldk + kch * 8);
  g.k0 = *(const u32x4*)pk; g.k1 = *(const u32x4*)(pk + 16 * ldk); g.k2 = *(const u32x4*)(pk + 32 * ldk); g.k3 = *(const u32x4*)(pk + 48 * ldk);
  const u16* pv = VTp + (unsigned)(vrow * ldv + vch * 8);
  g.v0 = *(const u32x4*)pv; g.v1 = *(const u32x4*)(pv + 32 * ldv); g.v2 = *(const u32x4*)(pv + 64 * ldv); g.v3 = *(const u32x4*)(pv + 96 * ldv);
}
DI void kv_store(const KVRegs& g, u16* Ks) {
  const int tid = otid();
  const int krow = tid >> 4, kch = tid & 15, vrow = tid >> 3, vch = tid & 7;
  u16* pk = Ks + krow * KS_LD + kch * 8;
  *(u32x4*)pk = g.k0; *(u32x4*)(pk + 16 * KS_LD) = g.k1; *(u32x4*)(pk + 32 * KS_LD) = g.k2; *(u32x4*)(pk + 48 * KS_LD) = g.k3;
  u16* pv = Ks + 64 * KS_LD + vrow * VT_LD + vch * 8;
  *(u32x4*)pv = g.v0; *(u32x4*)(pv + 32 * VT_LD) = g.v1; *(u32x4*)(pv + 64 * VT_LD) = g.v2; *(u32x4*)(pv + 96 * VT_LD) = g.v3;
}
constexpr int KVBUF = 64 * KS_LD + 128 * VT_LD;

DI float lam_value(const Params& p) {
  float s0 = 0.f, s1 = 0.f;
#pragma unroll 1
  for (int i = 0; i < 64; ++i) { s0 += p.lam_vec[i] * p.lam_vec[64 + i]; s1 += p.lam_vec[128 + i] * p.lam_vec[192 + i]; }
  return __expf(s0) - __expf(s1) + 0.2f;
}

DI void epi_diff(const Params& p, f32x16 (&o)[4], unsigned tok, int hh, int h) {
  float ss = 0.f;
#pragma unroll
  for (int d = 0; d < 4; ++d)
#pragma unroll
    for (int i = 0; i < 16; ++i) ss += o[d][i] * o[d][i];
  ss += __shfl_xor(ss, 32);
  const float rstd = rsqrtf(ss * (1.f / 128.f) + EPSF) * 0.8f;
  const u16* ZB = (const u16*)(p.ws + OFF_ZB); u16* MIXB = (u16*)(p.ws + OFF_QB);
#pragma unroll
  for (int d = 0; d < 4; ++d)
#pragma unroll
    for (int q = 0; q < 4; ++q) {
      if ((q & 1) == 0) asm volatile("" ::: "memory");
      const int dv = d * 32 + 8 * q + 4 * h;
      const uint2 zz = *(const uint2*)(ZB + tok * 512 + hh * 128 + dv);
      const float4 gg = *(const float4*)(p.g_sub + dv);
      float v0 = o[d][4 * q] * rstd * gg.x * silu(bflo(zz.x)), v1 = o[d][4 * q + 1] * rstd * gg.y * silu(bfhi(zz.x));
      float v2 = o[d][4 * q + 2] * rstd * gg.z * silu(bflo(zz.y)), v3 = o[d][4 * q + 3] * rstd * gg.w * silu(bfhi(zz.y));
      *(uint2*)(MIXB + tok * 512 + hh * 128 + dv) = make_uint2(pk2(v0, v1), pk2(v2, v3));
    }
}
DI void epi_mem(const Params& p, f32x16 (&o)[4], unsigned tok, int hh, int h) {
  const u16* ZC = (const u16*)(p.ws + OFF_ZC); u16* MIXC = (u16*)(p.ws + OFF_QC);
#pragma unroll
  for (int d = 0; d < 4; ++d)
#pragma unroll
    for (int q = 0; q < 4; ++q) {
      if ((q & 1) == 0) asm volatile("" ::: "memory");
      const int dv = d * 32 + 8 * q + 4 * h;
      const uint2 zz = *(const uint2*)(ZC + tok * 512 + hh * 128 + dv);
      float v0 = o[d][4 * q] * silu(bflo(zz.x)), v1 = o[d][4 * q + 1] * silu(bfhi(zz.x));
      float v2 = o[d][4 * q + 2] * silu(bflo(zz.y)), v3 = o[d][4 * q + 3] * silu(bfhi(zz.y));
      *(uint2*)(MIXC + tok * 512 + hh * 128 + dv) = make_uint2(pk2(v0, v1), pk2(v2, v3));
    }
}

constexpr float LOG2E = 1.4426950408889634f;

DI void attn_b_prompt(const Params& p, int bh, int c) {
  const int tid = otid(), w = tid >> 6, lane = tid & 63, r = lane & 31, h = lane >> 5;
  const int b = bh >> 2, hh = bh & 3, map = w >> 1, qsub = w & 1;
  const u16* QB = (const u16*)(p.ws + OFF_QB); const u16* KB = (const u16*)(p.ws + OFF_KB); const u16* VBT = (const u16*)(p.ws + OFF_VBT);
  const unsigned tok = (unsigned)b * 8192 + c * 64 + qsub * 32 + r;
  AttnSt<1, 4, 2> st;
  attn_init(st, QB + tok * 512 + hh * 128 + map * 64, h);
  const int ntiles = c + 1;
  const float sc = 0.125f * LOG2E;
  const u16* Kbase = KB + ((size_t)b * 8192) * 512 + hh * 128; const u16* VTbase = VBT + ((size_t)(b * 4 + hh) * 128) * 8192;
  KVRegs g;
  kv_load(g, Kbase, 512, VTbase, 8192);
  __syncthreads();
  kv_store(g, (u16*)smem);
  __syncthreads();
  for (int kt = 0; kt < ntiles; ++kt) {
    if (kt + 1 < ntiles) kv_load(g, Kbase + (unsigned)((kt + 1) * 64 * 512), 512, VTbase + (kt + 1) * 64, 8192);
    attn_step<1, 4, 2>(st, (const u16*)smem + (kt & 1) * KVBUF, 0, map * 64, sc);
    if (kt + 1 < ntiles) kv_store(g, (u16*)smem + ((kt + 1) & 1) * KVBUF);
    __syncthreads();
  }
  const float lam = lam_value(p);
  const float l = st.l[0] + __shfl_xor(st.l[0], 32);
  const float inv = (map == 0 ? 1.f : lam) / l;
#pragma unroll
  for (int d = 0; d < 4; ++d)
#pragma unroll
    for (int i = 0; i < 16; ++i) st.O[0][d][i] *= inv;
  float* slot = (float*)smem + qsub * 4096;
  if (map == 1) {
#pragma unroll
    for (int d = 0; d < 4; ++d)
#pragma unroll
      for (int i = 0; i < 16; ++i) slot[(d * 16 + i) * 64 + lane] = st.O[0][d][i];
  }
  __syncthreads();
  if (map == 0) {
#pragma unroll
    for (int d = 0; d < 4; ++d)
#pragma unroll
      for (int i = 0; i < 16; ++i) st.O[0][d][i] -= slot[(d * 16 + i) * 64 + lane];
    epi_diff(p, st.O[0], tok, hh, h);
  }
  __syncthreads();
}

DI void attn_step2q(AttnSt<2, 4, 2>& st, const u16* Ks, const u16* Qs, float sc) {
  const u16* Vt = Ks + 64 * KS_LD;
  const int tid = otid(), lane = tid & 63, r = lane & 31, h = lane >> 5, wq = tid >> 6;
#pragma unroll
  for (int T = 0; T < 2; ++T) {
    asm volatile("" ::: "memory");
    f32x16 s[2];
#pragma unroll
    for (int mm = 0; mm < 2; ++mm) {
      s[mm] = zero16();
#pragma unroll
      for (int ks = 0; ks < 4; ++ks) {
        bf16x8 a = *(const bf16x8*)(Ks + (T * 32 + r) * KS_LD + mm * 64 + ks * 16 + h * 8);
        bf16x8 q = *(const bf16x8*)(Qs + (wq * 32 + r) * 136 + mm * 64 + ks * 16 + h * 8);
        s[mm] = MFMA(a, q, s[mm]);
      }
    }
#pragma unroll
    for (int mm = 0; mm < 2; ++mm) {
      float mx = -1e30f;
#pragma unroll
      for (int i = 0; i < 16; ++i) mx = fmaxf(mx, s[mm][i]);
      mx = fmaxf(mx, __shfl_xor(mx, 32));
      const float mxs = mx * sc;
      if (__builtin_amdgcn_ballot_w64(mxs > st.m[mm] + 8.f) != 0) {
        const float mnew = fmaxf(st.m[mm], mxs);
        const float alpha = __builtin_amdgcn_exp2f(st.m[mm] - mnew);
        st.m[mm] = mnew; st.l[mm] *= alpha;
#pragma unroll
        for (int d = 0; d < 4; ++d)
#pragma unroll
          for (int i = 0; i < 16; ++i) st.O[mm][d][i] *= alpha;
      }
      const float mref = st.m[mm];
      float rs = 0.f;
#pragma unroll
      for (int i = 0; i < 16; ++i) { float pv = __builtin_amdgcn_exp2f(s[mm][i] * sc - mref); s[mm][i] = pv; rs += pv; }
      st.l[mm] += rs;
    }
#pragma unroll
    for (int t = 0; t < 2; ++t) {
      asm volatile("" ::: "memory");
      const bf16x8 pb0 = pack8(s[0], t), pb1 = pack8(s[1], t);
#pragma unroll
      for (int d = 0; d < 4; ++d) {
        bf16x8 a = *(const bf16x8*)(Vt + (d * 32 + r) * VT_LD + T * 32 + 16 * t + 8 * h);
        st.O[0][d] = MFMA(a, pb0, st.O[0][d]);
        st.O[1][d] = MFMA(a, pb1, st.O[1][d]);
      }
    }
  }
}
DI void attn_b_prompt2(const Params& p, int bh, int j) {
  const int b = bh >> 2, hh = bh & 3;
  const u16* QB = (const u16*)(p.ws + OFF_QB); const u16* KB = (const u16*)(p.ws + OFF_KB); const u16* VBT = (const u16*)(p.ws + OFF_VBT);
  AttnSt<2, 4, 2> st;
  attn_init(st, QB, 0, false);
  const int ntiles = 2 * j + 2;
  const float sc = 0.125f * LOG2E;
  const u16* Kbase = KB + ((size_t)b * 8192) * 512 + hh * 128; const u16* VTbase = VBT + ((size_t)(b * 4 + hh) * 128) * 8192;
  u16* Qs = (u16*)smem + KVBUF;
  KVRegs g;
  kv_load(g, Kbase, 512, VTbase, 8192);
  __syncthreads();
  {
    const int tid = otid();
    const u16* qsrc = QB + ((unsigned)b * 8192 + j * 128) * 512 + hh * 128;
#pragma unroll
    for (int i = 0; i < 8; ++i) { const int c = tid + 256 * i, row = c >> 4, ch = c & 15; *(uint4*)(Qs + row * 136 + ch * 8) = *(const uint4*)(qsrc + (unsigned)row * 512 + ch * 8); }
  }
  kv_store(g, (u16*)smem);
  __syncthreads();
  for (int kt = 0; kt < ntiles; ++kt) {
    if (kt + 1 < ntiles) kv_load(g, Kbase + (unsigned)((kt + 1) * 64 * 512), 512, VTbase + (kt + 1) * 64, 8192);
    if (kt < ntiles - 1 || (otid() >> 6) >= 2) attn_step2q(st, (const u16*)smem, Qs, sc);
    __syncthreads();
    if (kt + 1 < ntiles) { kv_store(g, (u16*)smem); __syncthreads(); }
  }
  const float lam = lam_value(p);
  const float l0 = st.l[0] + __shfl_xor(st.l[0], 32), l1 = st.l[1] + __shfl_xor(st.l[1], 32);
  const float i0 = 1.f / l0, i1 = lam / l1;
#pragma unroll
  for (int d = 0; d < 4; ++d)
#pragma unroll
    for (int i = 0; i < 16; ++i) st.O[0][d][i] = st.O[0][d][i] * i0 - st.O[1][d][i] * i1;
  const int tid = otid(), w = tid >> 6, lane = tid & 63, r = lane & 31, h = lane >> 5;
  const unsigned tok = (unsigned)b * 8192 + j * 128 + w * 32 + r;
  epi_diff(p, st.O[0], tok, hh, h);
}

DI void attn_c_prompt(const Params& p, int qt, int hh) {
  const int tid = otid(), w = tid >> 6, lane = tid & 63, r = lane & 31, h = lane >> 5;
  const u16* QC = (const u16*)(p.ws + OFF_QC); const u16* MEMK = (const u16*)(p.ws + OFF_MEMK); const u16* MEMVT = (const u16*)(p.ws + OFF_MEMVT);
  const unsigned tok = (unsigned)qt * 128 + w * 32 + r;
  const int b = qt >> 6;
  AttnSt<1, 8, 2> st;
  attn_init(st, QC + tok * 512 + hh * 128, h);
  const float sc = 0.08838834764831845f * LOG2E;
  const u16* Kbase = MEMK + ((size_t)b * 256) * 512 + hh * 128; const u16* VTbase = MEMVT + ((size_t)(b * 4 + hh) * 128) * 256;
  KVRegs g;
  kv_load(g, Kbase, 512, VTbase, 256);
  __syncthreads();
  kv_store(g, (u16*)smem);
  __syncthreads();
  for (int kt = 0; kt < 4; ++kt) {
    if (kt + 1 < 4) kv_load(g, Kbase + (unsigned)((kt + 1) * 64 * 512), 512, VTbase + (kt + 1) * 64, 256);
    attn_step<1, 8, 2>(st, (const u16*)smem + (kt & 1) * KVBUF, 0, 0, sc);
    if (kt + 1 < 4) kv_store(g, (u16*)smem + ((kt + 1) & 1) * KVBUF);
    __syncthreads();
  }
  float l0 = st.l[0] + __shfl_xor(st.l[0], 32);
  const float i0 = 1.f / l0;
#pragma unroll
  for (int d = 0; d < 4; ++d)
#pragma unroll
    for (int i = 0; i < 16; ++i) st.O[0][d][i] *= i0;
  epi_mem(p, st.O[0], tok, hh, h);
}

template <bool DIFF>
DI void attn_sample(const Params& p, int b, int hh) {
  const int tid = otid(), w = tid >> 6, lane = tid & 63, r = lane & 31, h = lane >> 5;
  const int map = w >> 1, half = w & 1;
  const bool active = DIFF || map == 0;
  const unsigned tok = (unsigned)NP + b * 32 + r;
  constexpr int KSN = DIFF ? 4 : 8;
  AttnSt<1, KSN, 1> st;
  const u16* Q = (const u16*)(p.ws + (DIFF ? OFF_QB : OFF_QC));
  attn_init(st, Q + tok * 512 + hh * 128 + (DIFF ? map * 64 : 0), h);
  const float sc = (DIFF ? 0.125f : 0.08838834764831845f) * LOG2E;
  const int dbase = DIFF ? map * 64 : 0;
  const int ncache = DIFF ? 64 : 4;
  const float* Kc = DIFF ? p.cache_diff_k : p.cache_mem_k; const float* Vc = DIFF ? p.cache_diff_v : p.cache_mem_v;
  const size_t T = DIFF ? 4096 : 256;
  for (int kt = 0; kt < ncache; ++kt) {
    __syncthreads();
    stage_f32(Kc + ((size_t)b * T + kt * 64) * 512 + hh * 128, 512, Vc + ((size_t)b * T + kt * 64) * 512 + hh * 128, 512);
    __syncthreads();
    if (active) attn_step<1, KSN, 1>(st, (const u16*)smem, half, dbase, sc);
  }
  if (DIFF) {
    const u16* KB = (const u16*)(p.ws + OFF_KB); const u16* VBT = (const u16*)(p.ws + OFF_VBT);
    __syncthreads();
    stage_bf16(KB + ((size_t)NP + b * 32) * 512 + hh * 128, 512, VBT + VBT_S_EL + ((size_t)(b * 4 + hh) * 128) * 32, 32, 32);
    __syncthreads();
    if (half == 0) attn_step<1, KSN, 1>(st, (const u16*)smem, 0, dbase, sc);
  }
  float* slot = (float*)smem + map * (64 * 64 + 128);
  __syncthreads();
  if (active && half == 1) {
#pragma unroll
    for (int d = 0; d < 4; ++d)
#pragma unroll
      for (int i = 0; i < 16; ++i) slot[(d * 16 + i) * 64 + lane] = st.O[0][d][i];
    slot[4096 + lane] = st.m[0]; slot[4160 + lane] = st.l[0];
  }
  __syncthreads();
  if (active && half == 0) {
    const float m2 = slot[4096 + lane], l2 = slot[4160 + lane];
    const float mn = fmaxf(st.m[0], m2), a1 = exp2f(st.m[0] - mn), a2 = exp2f(m2 - mn);
    float l = st.l[0] * a1 + l2 * a2;
    l += __shfl_xor(l, 32);
    const float inv = 1.f / l;
#pragma unroll
    for (int d = 0; d < 4; ++d)
#pragma unroll
      for (int i = 0; i < 16; ++i) st.O[0][d][i] = (st.O[0][d][i] * a1 + slot[(d * 16 + i) * 64 + lane] * a2) * inv;
  }
  __syncthreads();
  if (DIFF) {
    float* s0 = (float*)smem;
    if (w == 2) {
#pragma unroll
      for (int d = 0; d < 4; ++d)
#pragma unroll
        for (int i = 0; i < 16; ++i) s0[(d * 16 + i) * 64 + lane] = st.O[0][d][i];
    }
    __syncthreads();
    if (w == 0) {
      const float lam = lam_value(p);
#pragma unroll
      for (int d = 0; d < 4; ++d)
#pragma unroll
        for (int i = 0; i < 16; ++i) st.O[0][d][i] -= lam * s0[(d * 16 + i) * 64 + lane];
      epi_diff(p, st.O[0], tok, hh, h);
    }
  } else {
    if (w == 0) epi_mem(p, st.O[0], tok, hh, h);
  }
  __syncthreads();
}

DI size_t wbuf_off(int task) { return task < 8192 ? (size_t)task * 8192 : (size_t)8192 * 8192 + (size_t)(task - 8192) * 4096; }
DI size_t att_off(int task) { return task < 8192 ? (size_t)task * 4096 : (size_t)8192 * 4096 + (size_t)(task - 8192) * 1024; }

template <int C>
DI void g1_task(const Params& p, int task) {
  constexpr bool SAMPLE = (C == 32);
  const int tid = otid(), w = tid >> 6, lane = tid & 63, r = lane & 31, h = lane >> 5;
  int b, n, hh;
  if (!SAMPLE) { hh = task & 7; n = (task >> 3) & 127; b = task >> 10; } else { int u = task - 8192; hh = u & 7; b = u >> 3; n = 0; }
  const unsigned tok0 = SAMPLE ? (unsigned)NP + b * 32 : (unsigned)b * 8192 + n * 64;
  u16* qs = (u16*)smem; u16* ks = qs + 64 * 136; u16* raw = ks + 64 * 136;
  float* Lf = (float*)smem;
  float* fG = (float*)(smem + 51968); float* fB = fG + 64; float* fE = fB + 64;
  u16* QKV = (u16*)(p.ws + OFF_QKV);
  const u16* HALO = (const u16*)((const char*)p.out + YO_HALO);
  u16* WBUF = (u16*)((char*)p.out + YO_W); u16* ATT = (u16*)((char*)p.out + YO_ATT);
  const float* BA = (const float*)(p.ws + OFF_BA); float* GL = (float*)(p.ws + OFF_GL);

  float* fD = fE + 64;
  float* cw = (float*)(smem + 52736 + 256);
  if (w == 0) {
    float g = 0.f, beta = 0.f;
    if (lane < C) {
      const float bb = BA[(tok0 + lane) * 16 + hh], aa = BA[(tok0 + lane) * 16 + 8 + hh];
      beta = 1.f / (1.f + __expf(-bb));
      const float xx = aa + p.dt_bias[hh];
      const float sp = xx > 20.f ? xx : log1pf(__expf(xx));
      g = -__expf(p.a_log[hh]) * sp;
    }
    for (int d = 1; d < 64; d <<= 1) { float t = __shfl_up(g, d); if (lane >= d) g += t; }
    const float glast = __shfl(g, C - 1);
    if (lane < C) { fG[lane] = g; fB[lane] = beta; fE[lane] = __expf(g); fD[lane] = __expf(glast - g); }
  }
  for (int idx = tid; idx < 384; idx += 256) {
    const int rw_ = idx >> 5, c4 = idx & 31, sec = rw_ >> 2, tap = rw_ & 3;
    *(float4*)(cw + rw_ * 128 + c4 * 4) = *(const float4*)(p.conv_w + (unsigned)(tap * 3072 + sec * 1024 + hh * 128 + c4 * 4));
  }
  __syncthreads();
  const int crow_ = tid >> 2, cq = tid & 3;
  if (crow_ < C) {
#pragma unroll 1
    for (int sec = 0; sec < 3; ++sec) {
      const int colg = sec * 1024 + hh * 128;
      float y[32]; float ss = 0.f;
#pragma unroll
      for (int c8 = 0; c8 < 4; ++c8) {
        const int col = cq * 32 + c8 * 8;
        uint4 xv[4];
#pragma unroll
        for (int i = 0; i < 4; ++i) {
          const int rr = crow_ + i;
          if (rr >= 3) xv[i] = *(const uint4*)(QKV + (tok0 + rr - 3) * 3072 + colg + col);
          else if (SAMPLE) {
            const float* cc = p.cache_conv + ((size_t)b * 3 + rr) * 3072 + colg + col;
            const float4 a = *(const float4*)cc, bq = *(const float4*)(cc + 4);
            xv[i] = make_uint4(pk2(a.x, a.y), pk2(a.z, a.w), pk2(bq.x, bq.y), pk2(bq.z, bq.w));
          } else if (n == 0) xv[i] = make_uint4(0, 0, 0, 0);
          else xv[i] = *(const uint4*)(HALO + ((size_t)((b * 128 + n - 1) * 3 + rr)) * 3072 + colg + col);
        }
        float acc8[8];
#pragma unroll
        for (int e = 0; e < 8; ++e) acc8[e] = 0.f;
#pragma unroll
        for (int i = 0; i < 4; ++i) {
          const float4 w0 = *(const float4*)(cw + (sec * 4 + i) * 128 + col), w1 = *(const float4*)(cw + (sec * 4 + i) * 128 + col + 4);
          acc8[0] += bflo(xv[i].x) * w0.x; acc8[1] += bfhi(xv[i].x) * w0.y; acc8[2] += bflo(xv[i].y) * w0.z; acc8[3] += bfhi(xv[i].y) * w0.w;
          acc8[4] += bflo(xv[i].z) * w1.x; acc8[5] += bfhi(xv[i].z) * w1.y; acc8[6] += bflo(xv[i].w) * w1.z; acc8[7] += bfhi(xv[i].w) * w1.w;
        }
#pragma unroll
        for (int e = 0; e < 8; ++e) { float v = silu(acc8[e]); y[c8 * 8 + e] = v; ss += v * v; }
      }
      float sc = 1.f;
      if (sec < 2) {
        ss += __shfl_xor(ss, 1); ss += __shfl_xor(ss, 2);
        sc = rsqrtf(ss + EPSF) * (sec == 0 ? 0.08838834764831845f : 1.f);
      }
      u16* dst = sec == 0 ? qs + crow_ * 136 + cq * 32 : (sec == 1 ? ks + crow_ * 136 + cq * 32 : raw + crow_ * 128 + cq * 32);
#pragma unroll
      for (int c8 = 0; c8 < 4; ++c8)
        *(uint4*)(dst + c8 * 8) = make_uint4(pk2(y[c8 * 8] * sc, y[c8 * 8 + 1] * sc), pk2(y[c8 * 8 + 2] * sc, y[c8 * 8 + 3] * sc), pk2(y[c8 * 8 + 4] * sc, y[c8 * 8 + 5] * sc), pk2(y[c8 * 8 + 6] * sc, y[c8 * 8 + 7] * sc));
    }
  }
  __syncthreads();
  const u16* vs = raw;
  const int ri = w >> 1, ci = w & 1;
  const bool act = SAMPLE ? (w == 0) : true;
  const bool lower = act && (ri >= ci);
  f32x16 kk = zero16(), qk = zero16();
  if (lower) {
#pragma unroll
    for (int s = 0; s < 8; ++s) {
      bf16x8 bk = *(const bf16x8*)(ks + (ci * 32 + r) * 136 + s * 16 + h * 8);
      bf16x8 ak = *(const bf16x8*)(ks + (ri * 32 + r) * 136 + s * 16 + h * 8);
      bf16x8 aq = *(const bf16x8*)(qs + (ri * 32 + r) * 136 + s * 16 + h * 8);
      kk = MFMA(ak, bk, kk); qk = MFMA(aq, bk, qk);
    }
  }
  __syncthreads();
  for (int idx = tid; idx < C * 16; idx += 256) {
    const int row = idx >> 4, ch = idx & 15;
    const uint4 v = *(const uint4*)(qs + row * 136 + ch * 8);
    const float e = fE[row];
    st16_wt(QKV + (tok0 + row) * 3072 + hh * 128 + ch * 8,
            make_uint4(pk2(bflo(v.x) * e, bfhi(v.x) * e), pk2(bflo(v.y) * e, bfhi(v.y) * e), pk2(bflo(v.z) * e, bfhi(v.z) * e), pk2(bflo(v.w) * e, bfhi(v.w) * e)));
  }
  {
    const float gl = fG[C - 1];
    for (int idx = tid; idx < 16 * C; idx += 256) {
      const int dk = idx & 127, c0 = (idx >> 7) * 8;
      float v[8];
#pragma unroll
      for (int j = 0; j < 8; ++j) v[j] = bf2f(ks[(c0 + j) * 136 + dk]) * fD[c0 + j];
      const int flat = dk * C + c0;
      const uint4 ov = make_uint4(pk2(v[0], v[1]), pk2(v[2], v[3]), pk2(v[4], v[5]), pk2(v[6], v[7]));
      st16_wt(QKV + (tok0 + (flat >> 7)) * 3072 + 1024 + hh * 128 + (flat & 127), ov);
    }
    if (tid == 0) __hip_atomic_store((unsigned*)GL + task, __float_as_uint(__expf(gl)), __ATOMIC_RELAXED, __HIP_MEMORY_SCOPE_AGENT);
  }
  __syncthreads();
  float* LT = (float*)smem;
  if (act) {
    const int col = ci * 32 + r;
    const float gc = fG[col];
#pragma unroll
    for (int i = 0; i < 16; ++i) {
      const int row = ri * 32 + crow(i, h);
      const float dec = __expf(fminf(fG[row] - gc, 0.f));
      if (lower) LT[col * 68 + row] = row > col ? fB[row] * kk[i] * dec : 0.f;
      st2_wt(ATT + att_off(task) + row * C + col, f2bf(row >= col ? qk[i] * dec : 0.f));
    }
  }
  __syncthreads();
  {
    const int cc = tid & 127; const bool isU = tid < 128;
    u16* X = isU ? (raw + cc) : (ks + cc);
    const int ld = isU ? 128 : 136;
#pragma unroll 1
    for (int ib = 0; ib < C / 8; ++ib) {
      float a[8];
#pragma unroll
      for (int ii = 0; ii < 8; ++ii) { const int i = ib * 8 + ii; a[ii] = bf2f(X[i * ld]) * (isU ? fB[i] : fB[i] * fE[i]); }
#pragma unroll 2
      for (int j = 0; j < ib * 8; ++j) {
        const float xj = bf2f(X[j * ld]);
        const float4 l0 = *(const float4*)(LT + j * 68 + ib * 8), l1 = *(const float4*)(LT + j * 68 + ib * 8 + 4);
        a[0] -= l0.x * xj; a[1] -= l0.y * xj; a[2] -= l0.z * xj; a[3] -= l0.w * xj;
        a[4] -= l1.x * xj; a[5] -= l1.y * xj; a[6] -= l1.z * xj; a[7] -= l1.w * xj;
      }
#pragma unroll
      for (int ii = 1; ii < 8; ++ii)
#pragma unroll
        for (int jj = 0; jj < ii; ++jj) a[ii] -= LT[(ib * 8 + jj) * 68 + ib * 8 + ii] * a[jj];
#pragma unroll
      for (int ii = 0; ii < 8; ++ii) X[(ib * 8 + ii) * ld] = f2bf(a[ii]);
    }
  }
  __syncthreads();
  {
    u16* wd = WBUF + wbuf_off(task);
    for (int idx = tid; idx < C * 16; idx += 256) {
      const int row = idx >> 4, ch = idx & 15;
      st16_wt(QKV + (tok0 + row) * 3072 + 2048 + hh * 128 + ch * 8, *(const uint4*)(raw + row * 128 + ch * 8));
      st16_wt(wd + row * 128 + ch * 8, *(const uint4*)(ks + row * 136 + ch * 8));
    }
  }
  asm volatile("s_waitcnt vmcnt(0)" ::: "memory");
  __syncthreads();
  if (tid == 0) {
    unsigned* cnt = (unsigned*)(p.ws + OFF_CTR) + 64 + (SAMPLE ? 512 + b * 8 + hh : (b * 8 + hh) * 8 + (n >> 4));
    __hip_atomic_fetch_add(cnt, 1u, __ATOMIC_RELAXED, __HIP_MEMORY_SCOPE_AGENT);
  }
  __syncthreads();
}

template <int RT>
DI void scan_task(const Params& p, int b, int hh) {
  constexpr int C = 32 * RT; constexpr bool SAMPLE = (RT == 1);
  constexpr int NI = C / 16, NA = (C == 64) ? 2 : 1;
  const int tid = otid(), w = tid >> 6, lane = tid & 63, r = lane & 31, h = lane >> 5;
  u16* wsm = (u16*)smem; u16* us = wsm + 64 * 136; u16* qds = us + 64 * 136; u16* kts = qds + 64 * 136; u16* asm_ = kts + 128 * 72;
  u16* QKV = (u16*)(p.ws + OFF_QKV);
  const u16* WBUF = (const u16*)((const char*)p.out + YO_W); const u16* ATT = (const u16*)((const char*)p.out + YO_ATT);
  const float* GL = (const float*)(p.ws + OFF_GL);
  f32x16 S[4];
  if (SAMPLE) {
#pragma unroll
    for (int d = 0; d < 4; ++d)
#pragma unroll
      for (int i = 0; i < 16; ++i) {
        const float* srow = p.state_gdn + (size_t)(b * 8 + hh) * 128 * 128 + (d * 32 + (i & 3) + 8 * (i >> 2)) * 128;
        S[d][i] = srow[(unsigned)(4 * h * 128 + w * 32 + r)];
      }
  } else {
#pragma unroll
    for (int d = 0; d < 4; ++d) S[d] = zero16();
  }
  const int nchunks = SAMPLE ? 1 : 128;
  auto wait_group = [&](int grp) {
    if (otid() == 0) {
      unsigned* cnt = (unsigned*)(p.ws + OFF_CTR) + 64 + (SAMPLE ? 512 + b * 8 + hh : (b * 8 + hh) * 8 + grp);
      const unsigned need = SAMPLE ? 1u : 16u;
      while (__hip_atomic_load(cnt, __ATOMIC_RELAXED, __HIP_MEMORY_SCOPE_AGENT) < need) __builtin_amdgcn_s_sleep(16);
      __builtin_amdgcn_fence(__ATOMIC_ACQUIRE, "agent");
      asm volatile("s_waitcnt vmcnt(0)" ::: "memory");
    }
    __syncthreads();
  };
  wait_group(0);
  u32x4 rw[NI], ru[NI], rq[NI], rk[NI], ra[NA];
  auto task_of = [&](int n) { return SAMPLE ? 8192 + b * 8 + hh : (b * 128 + n) * 8 + hh; };
  auto tok_of = [&](int n) { return SAMPLE ? (unsigned)NP + b * 32 : (unsigned)b * 8192 + n * 64; };
#define SCAN_LOAD1(n_)                                                                                   \
  {                                                                                                      \
    const int tid = otid();                                                            \
    const u16* wsrc = WBUF + wbuf_off(task_of(n_)); const unsigned tk = tok_of(n_);                      \
    const unsigned lo_w = (unsigned)((tid >> 4) * 128 + (tid & 15) * 8), lo_q = (unsigned)((tid >> 4) * 3072 + (tid & 15) * 8); \
    _Pragma("unroll") for (int i = 0; i < NI; ++i) {                                                     \
      const u16* qb_ = QKV + (size_t)(tk + 16 * i) * 3072 + hh * 128;                         \
      rw[i] = *(const u32x4*)((wsrc + 16 * i * 128) + lo_w);                                             \
      ru[i] = *(const u32x4*)((qb_ + 2048) + lo_q);                                                      \
    }                                                                                                    \
  }
#define SCAN_STORE1()                                                                                    \
  {                                                                                                      \
    const int tid = otid();                                                            \
    _Pragma("unroll") for (int i = 0; i < NI; ++i) {                                                     \
      const int idx = tid + 256 * i, row = idx >> 4, ch = idx & 15;                                      \
      *(u32x4*)(wsm + row * 136 + ch * 8) = rw[i]; *(u32x4*)(us + row * 136 + ch * 8) = ru[i];           \
    }                                                                                                    \
  }
#define SCAN_LOAD2(n_)                                                                                   \
  {                                                                                                      \
    const int tid = otid();                                                            \
    const u16* asrc = ATT + att_off(task_of(n_)); const unsigned tk = tok_of(n_);                        \
    const unsigned lo_k = (unsigned)((tid >> 4) * 3072 + (tid & 15) * 8);                                \
    _Pragma("unroll") for (int i = 0; i < NI; ++i) {                                                     \
      const u16* qb_ = QKV + (size_t)(tk + 16 * i) * 3072 + hh * 128;                         \
      rq[i] = *(const u32x4*)(qb_ + lo_k);                                                               \
      rk[i] = *(const u32x4*)((qb_ + 1024) + lo_k);                                                      \
    }                                                                                                    \
    _Pragma("unroll") for (int i = 0; i < NA; ++i) {                                                     \
      const int idx = tid + 256 * i;                                                                     \
      if (idx < C * C / 8) ra[i] = *(const u32x4*)(asrc + (idx / (C / 8)) * C + (idx % (C / 8)) * 8);    \
    }                                                                                                    \
  }
#define SCAN_STORE2()                                                                                    \
  {                                                                                                      \
    const int tid = otid();                                                            \
    _Pragma("unroll") for (int i = 0; i < NI; ++i) {                                                     \
      const int idx = tid + 256 * i, row = idx >> 4, ch = idx & 15;                                      \
      *(u32x4*)(qds + row * 136 + ch * 8) = rq[i];                                                       \
      const int f8 = idx * 8;                                                                            \
      *(u32x4*)(kts + (f8 / C) * 72 + (f8 % C)) = rk[i];                                                 \
    }                                                                                                    \
    _Pragma("unroll") for (int i = 0; i < NA; ++i) {                                                     \
      const int idx = tid + 256 * i;                                                                     \
      if (idx < C * C / 8) *(u32x4*)(asm_ + (idx / (C / 8)) * 72 + (idx % (C / 8)) * 8) = ra[i];         \
    }                                                                                                    \
  }
  __syncthreads();
  SCAN_LOAD1(0); SCAN_LOAD2(0);
  SCAN_STORE1(); SCAN_STORE2();
  __syncthreads();
  for (int n = 0; n < nchunks; ++n) {
    const bool have_next = n + 1 < nchunks;
    const unsigned tok0 = tok_of(n);
    const int tid = otid(), w = tid >> 6, lane = tid & 63, r = lane & 31, h = lane >> 5;
    if (have_next && ((n + 1) & 15) == 0) wait_group((n + 1) >> 4);
    if (have_next) SCAN_LOAD1(n + 1);
    const float gl = __uint_as_float(__hip_atomic_load((const unsigned*)GL + task_of(n), __ATOMIC_RELAXED, __HIP_MEMORY_SCOPE_AGENT));
    f32x16 e[RT];
#pragma unroll
    for (int rt = 0; rt < RT; ++rt)
#pragma unroll
      for (int i = 0; i < 16; ++i) e[rt][i] = -bf2f(us[(rt * 32 + crow(i, h)) * 136 + w * 32 + r]);
#pragma unroll
    for (int d = 0; d < 4; ++d)
#pragma unroll
      for (int t = 0; t < 2; ++t) {
        asm volatile("" ::: "memory");
        const bf16x8 sb = pack8(S[d], t);
#pragma unroll
        for (int rt = 0; rt < RT; ++rt) {
          bf16x8 aw = ld_a2(wsm + (rt * 32 + r) * 136 + d * 32 + 16 * t + 4 * h);
          e[rt] = MFMA(aw, sb, e[rt]);
        }
      }
    __syncthreads();
    if (have_next) { SCAN_STORE1(); SCAN_LOAD2(n + 1); }
    bf16x8 ebf[RT][2];
#pragma unroll
    for (int rt = 0; rt < RT; ++rt) {
#pragma unroll
      for (int i = 0; i < 16; ++i) e[rt][i] = -e[rt][i];
      ebf[rt][0] = pack8(e[rt], 0); ebf[rt][1] = pack8(e[rt], 1);
    }
#pragma unroll 1
    for (int rt = 0; rt < RT; ++rt) {
      const int tid = otid(), w = tid >> 6, lane = tid & 63, r = lane & 31, h = lane >> 5;
      f32x16 o = zero16();
#pragma unroll
      for (int d = 0; d < 4; ++d)
#pragma unroll
        for (int t = 0; t < 2; ++t) {
          if (t == 0) asm volatile("" ::: "memory");
          bf16x8 aq = ld_a2(qds + (rt * 32 + r) * 136 + d * 32 + 16 * t + 4 * h);
          o = MFMA(aq, pack8(S[d], t), o);
        }
#pragma unroll
      for (int jt = 0; jt < RT; ++jt)
#pragma unroll
        for (int t = 0; t < 2; ++t) {
          if (t == 0) asm volatile("" ::: "memory");
          bf16x8 aa = ld_a2(asm_ + (rt * 32 + r) * 72 + jt * 32 + 16 * t + 4 * h);
          o = MFMA(aa, ebf[jt][t], o);
        }
#pragma unroll
      for (int i = 0; i < 16; ++i) {
        u16* orow = QKV + (size_t)(tok0 + rt * 32 + (i & 3) + 8 * (i >> 2)) * 3072 + 2048 + hh * 128;
        orow[(unsigned)(4 * h * 3072 + w * 32 + r)] = f2bf(o[i]);
      }
    }
    const int tid3 = otid(), lane3 = tid3 & 63, r3 = lane3 & 31, h3 = lane3 >> 5;
#pragma unroll
    for (int d = 0; d < 4; ++d)
#pragma unroll
      for (int i = 0; i < 16; ++i) S[d][i] *= gl;
#pragma unroll
    for (int jt = 0; jt < RT; ++jt)
#pragma unroll
      for (int t = 0; t < 2; ++t) {
        asm volatile("" ::: "memory");
        const bf16x8 eb = ebf[jt][t];
#pragma unroll
        for (int d = 0; d < 4; ++d) {
          bf16x8 ak = ld_a2(kts + (d * 32 + r3) * 72 + jt * 32 + 16 * t + 4 * h3);
          S[d] = MFMA(ak, eb, S[d]);
        }
      }
    __syncthreads();
    if (have_next) SCAN_STORE2();
    __syncthreads();
  }
#undef SCAN_LOAD1
#undef SCAN_STORE1
#undef SCAN_LOAD2
#undef SCAN_STORE2
  asm volatile("s_waitcnt vmcnt(0)" ::: "memory");
  __syncthreads();
  __builtin_amdgcn_fence(__ATOMIC_ACQUIRE, "agent");
  {
    const int tidf = otid(), l8 = tidf & 7;
    const int nrows = SAMPLE ? 32 : 8192; const unsigned tokb = SAMPLE ? (unsigned)NP + b * 32 : (unsigned)b * 8192;
    const u16* ZA = (const u16*)(p.ws + OFF_ZA);
    const float* gp = p.g_gdn + l8 * 16;
    for (int row = tidf >> 3; row < nrows; row += 32) {
      u16* op = QKV + (tokb + row) * 3072 + 2048 + hh * 128 + l8 * 16;
      const u16* zp = ZA + (tokb + row) * 1024 + hh * 128 + l8 * 16;
      const uint4 o0 = *(const uint4*)op, o1 = *(const uint4*)(op + 8);
      const uint4 z0 = *(const uint4*)zp, z1 = *(const uint4*)(zp + 8);
      float v[16] = {bflo(o0.x), bfhi(o0.x), bflo(o0.y), bfhi(o0.y), bflo(o0.z), bfhi(o0.z), bflo(o0.w), bfhi(o0.w),
                     bflo(o1.x), bfhi(o1.x), bflo(o1.y), bfhi(o1.y), bflo(o1.z), bfhi(o1.z), bflo(o1.w), bfhi(o1.w)};
      float zz[16] = {bflo(z0.x), bfhi(z0.x), bflo(z0.y), bfhi(z0.y), bflo(z0.z), bfhi(z0.z), bflo(z0.w), bfhi(z0.w),
                      bflo(z1.x), bfhi(z1.x), bflo(z1.y), bfhi(z1.y), bflo(z1.z), bfhi(z1.z), bflo(z1.w), bfhi(z1.w)};
      float ss = 0.f;
#pragma unroll
      for (int j = 0; j < 16; ++j) ss += v[j] * v[j];
      ss += __shfl_xor(ss, 1); ss += __shfl_xor(ss, 2); ss += __shfl_xor(ss, 4);
      const float rstd = rsqrtf(ss * (1.f / 128.f) + EPSF);
      unsigned ow[8];
#pragma unroll
      for (int j = 0; j < 8; ++j) ow[j] = pk2(v[2 * j] * rstd * gp[2 * j] * silu(zz[2 * j]), v[2 * j + 1] * rstd * gp[2 * j + 1] * silu(zz[2 * j + 1]));
      *(uint4*)op = make_uint4(ow[0], ow[1], ow[2], ow[3]);
      *(uint4*)(op + 8) = make_uint4(ow[4], ow[5], ow[6], ow[7]);
    }
  }
  float* so = p.out + (SAMPLE ? O_SS : O_SP) + (size_t)(b * 8 + hh) * 128 * 128;
#pragma unroll
  for (int d = 0; d < 4; ++d)
#pragma unroll
    for (int i = 0; i < 16; ++i) { float* srow = so + (d * 32 + (i & 3) + 8 * (i >> 2)) * 128; srow[(unsigned)(4 * h * 128 + w * 32 + r)] = S[d][i]; }
}

DI void phase2(const Params& p) {
  __shared__ int s_task;
  unsigned* ctr = (unsigned*)(p.ws + OFF_CTR);
  constexpr int NPRE = 192 + 128 + 8192 + 64, NPOST = 2048 + 64;
  int stage = 0, steal = 0; const unsigned xcc = xcc_id();
  while (true) {
    __syncthreads();
    if (otid() == 0) {
      int code = -1;
      if (stage == 0) { const int t = (int)atomicAdd(ctr, 1u); if (t < NPRE) code = t; else stage = 1; }
      if (stage == 1) { const int q = (int)atomicAdd(ctr + 8, 1u); if (q < 2048) code = NPRE + q; else stage = 2; }
      if (stage == 2) { const int t = (int)atomicAdd(ctr + 1, 1u); if (t < NPOST) code = NPRE + 4096 + t; }
      s_task = code;
    }
    __syncthreads();
    int t = __builtin_amdgcn_readfirstlane(s_task);
    if (t < 0) break;
#ifndef TM
#define TM 127
#endif
    if (t < 64) { if (TM & 64) scan_task<2>(p, t >> 3, t & 7); continue; }
    if (t < 192) { if (TM & 64) scan_task<1>(p, (t - 64) >> 3, (t - 64) & 7); continue; }
    t -= 192;
    if (t < 128) { if (TM & 8) g1_task<32>(p, 8192 + t); continue; }
    t -= 128;
    if (t < 8192) { if (TM & 4) { const int n = t >> 6, s = t & 63; g1_task<64>(p, ((s >> 3) * 128 + n) * 8 + (s & 7)); } continue; }
    t -= 8192;
    if (t < 64) { if (TM & 2) attn_sample<true>(p, t >> 2, t & 3); continue; }
    t -= 64;
    if (t < 4096) {
      if (TM & 1) { if (t < 2048) attn_b_prompt2(p, t & 31, 63 - (t >> 5)); }
      continue;
    }
    t -= 4096;
    if (t < 64) { if (TM & 32) attn_sample<false>(p, t >> 2, t & 3); continue; }
    t -= 64;
    if (TM & 16) attn_c_prompt(p, t >> 2, t & 3);
  }
}

DI void phase3b(const Params& p) {
  const int tid = otid(), w = tid >> 6, lane = tid & 63;
  u16* QKV = (u16*)(p.ws + OFF_QKV); const u16* ZA = (const u16*)(p.ws + OFF_ZA);
  for (int row = blockIdx.x * 4 + w; row < NT; row += gridDim.x * 4) {
    u16* op = QKV + (unsigned)row * 3072u + 2048 + lane * 16;
    const u16* zp = ZA + (unsigned)row * 1024u + lane * 16;
    const uint4 o0 = *(const uint4*)op, o1 = *(const uint4*)(op + 8);
    const uint4 z0 = *(const uint4*)zp, z1 = *(const uint4*)(zp + 8);
    float v[16] = {bflo(o0.x), bfhi(o0.x), bflo(o0.y), bfhi(o0.y), bflo(o0.z), bfhi(o0.z), bflo(o0.w), bfhi(o0.w),
                   bflo(o1.x), bfhi(o1.x), bflo(o1.y), bfhi(o1.y), bflo(o1.z), bfhi(o1.z), bflo(o1.w), bfhi(o1.w)};
    float zz[16] = {bflo(z0.x), bfhi(z0.x), bflo(z0.y), bfhi(z0.y), bflo(z0.z), bfhi(z0.z), bflo(z0.w), bfhi(z0.w),
                    bflo(z1.x), bfhi(z1.x), bflo(z1.y), bfhi(z1.y), bflo(z1.z), bfhi(z1.z), bflo(z1.w), bfhi(z1.w)};
    float ss = 0.f;
#pragma unroll
    for (int j = 0; j < 16; ++j) ss += v[j] * v[j];
    ss += __shfl_xor(ss, 1); ss += __shfl_xor(ss, 2); ss += __shfl_xor(ss, 4);
    const float rstd = rsqrtf(ss * (1.f / 128.f) + EPSF);
    const float* gp = p.g_gdn + (lane & 7) * 16;
    unsigned ow[8];
#pragma unroll
    for (int j = 0; j < 8; ++j) ow[j] = pk2(v[2 * j] * rstd * gp[2 * j] * silu(zz[2 * j]), v[2 * j + 1] * rstd * gp[2 * j + 1] * silu(zz[2 * j + 1]));
    *(uint4*)op = make_uint4(ow[0], ow[1], ow[2], ow[3]);
    *(uint4*)(op + 8) = make_uint4(ow[4], ow[5], ow[6], ow[7]);
  }
}

DI void phase4(const Params& p) {
  const int tid = otid(), w = tid >> 6, lane = tid & 63, r = lane & 31, h = lane >> 5, wm = w >> 1, wn = w & 1;
  const u16* QKV = (const u16*)(p.ws + OFF_QKV); const u16* MIXB = (const u16*)(p.ws + OFF_QB); const u16* MIXC = (const u16*)(p.ws + OFF_QC);
  const u16* WoutT = (const u16*)(p.ws + OFF_WOUTT);
  __shared__ int s_t4;
  int steal4 = 0; const unsigned xcc4 = xcc_id();
  while (true) {
    __syncthreads();
    if (otid() == 0) s_t4 = xq_fetch((unsigned*)(p.ws + OFF_CTR) + 24, 258, xcc4, steal4);
    __syncthreads();
    const int tq = __builtin_amdgcn_readfirstlane(s_t4);
    if (tq < 0) break;
    const int xq = tq / 258, jq = tq % 258;
    const int nt = xq & 3, mt = jq * 2 + (xq >> 2), m0 = mt * 128, n0 = nt * 256;
    f32x16 acc[2][4];
#pragma unroll
    for (int a = 0; a < 2; ++a)
#pragma unroll
      for (int b = 0; b < 4; ++b) acc[a][b] = zero16();
    gemm_core<true>(QKV + (size_t)m0 * 3072 + 2048, 3072, MIXB + (size_t)m0 * 512, 512, MIXC + (size_t)m0 * 512, 512, 16, 24, WoutT + (size_t)n0 * 2048, 2048, 32, acc);
#pragma unroll
    for (int rt = 0; rt < 2; ++rt) {
      const int row = m0 + wm * 64 + rt * 32 + r;
      const float* xr = row < NP ? p.x_prompt + (unsigned)(row * 1024) : p.x_sample + (unsigned)((row - NP) * 1024);
      float* yr = p.out + (unsigned)(row * 1024);
#pragma unroll
      for (int ct = 0; ct < 4; ++ct)
#pragma unroll
        for (int q = 0; q < 4; ++q) {
          const int col = n0 + wn * 128 + ct * 32 + 8 * q + 4 * h;
          const float4 xv = *(const float4*)(xr + col);
          st16_wt(yr + col, make_uint4(__float_as_uint(xv.x + acc[rt][ct][4 * q]), __float_as_uint(xv.y + acc[rt][ct][4 * q + 1]), __float_as_uint(xv.z + acc[rt][ct][4 * q + 2]), __float_as_uint(xv.w + acc[rt][ct][4 * q + 3])));
        }
    }
    asm volatile("s_waitcnt vmcnt(0)" ::: "memory");
    __syncthreads();
    if (otid() == 0) {
      const unsigned old = __hip_atomic_fetch_add((unsigned*)(p.ws + OFF_CTR) + 1024 + mt, 1u, __ATOMIC_RELAXED, __HIP_MEMORY_SCOPE_AGENT);
      s_t4 = (old == 3u) ? 1 : 0;
    }
    __syncthreads();
    if (__builtin_amdgcn_readfirstlane(s_t4)) {
      __builtin_amdgcn_fence(__ATOMIC_ACQUIRE, "agent");
      asm volatile("s_waitcnt vmcnt(0)" ::: "memory");
      const int tid2 = otid(), w2 = tid2 >> 6, lane2 = tid2 & 63;
#pragma unroll 2
      for (int rr = 0; rr < 32; ++rr) {
        float* y = p.out + (unsigned)((m0 + w2 * 32 + rr) * 1024);
        float4 xv[4]; float ss = 0.f;
#pragma unroll
        for (int i = 0; i < 4; ++i) { xv[i] = *(const float4*)(y + i * 256 + lane2 * 4); ss += xv[i].x * xv[i].x + xv[i].y * xv[i].y + xv[i].z * xv[i].z + xv[i].w * xv[i].w; }
        ss = wave_sum(ss);
        const float rstd = rsqrtf(ss * (1.f / 1024.f) + EPSF);
#pragma unroll
        for (int i = 0; i < 4; ++i) {
          const float4 gv = *(const float4*)(p.g_final + i * 256 + lane2 * 4);
          xv[i].x *= rstd * gv.x; xv[i].y *= rstd * gv.y; xv[i].z *= rstd * gv.z; xv[i].w *= rstd * gv.w;
          *(float4*)(y + i * 256 + lane2 * 4) = xv[i];
        }
      }
    }
  }
}

DI void phase5(const Params& p) {
  const int tid = otid(), w = tid >> 6, lane = tid & 63;
  for (int row = blockIdx.x * 4 + w; row < NT; row += gridDim.x * 4) {
    float* y = p.out + (size_t)row * 1024;
    float4 xv[4]; float ss = 0.f;
#pragma unroll
    for (int i = 0; i < 4; ++i) { xv[i] = *(const float4*)(y + i * 256 + lane * 4); ss += xv[i].x * xv[i].x + xv[i].y * xv[i].y + xv[i].z * xv[i].z + xv[i].w * xv[i].w; }
    ss = wave_sum(ss);
    const float rstd = rsqrtf(ss * (1.f / 1024.f) + EPSF);
#pragma unroll
    for (int i = 0; i < 4; ++i) {
      float4 gv = *(const float4*)(p.g_final + i * 256 + lane * 4);
      xv[i].x *= rstd * gv.x; xv[i].y *= rstd * gv.y; xv[i].z *= rstd * gv.z; xv[i].w *= rstd * gv.w;
      *(float4*)(y + i * 256 + lane * 4) = xv[i];
    }
  }
}

__global__ void __launch_bounds__(256, 2) mega(Params p, int ph_lo, int ph_hi) {
  cg::grid_group grid = cg::this_grid();
#ifndef PM
#define PM 63
#endif
  if (ph_lo <= 0 && ph_hi >= 0) { if (PM & 1) phase0(p); }
  if (ph_lo <= 0 && ph_hi >= 1) grid.sync();
  if (ph_lo <= 1 && ph_hi >= 1) { if (PM & 2) phase1(p); }
  if (ph_lo <= 1 && ph_hi >= 2) grid.sync();
  if (ph_lo <= 2 && ph_hi >= 2) { if (PM & 4) phase2(p); }
  if (ph_lo <= 2 && ph_hi >= 4) grid.sync();
  if (ph_lo <= 4 && ph_hi >= 4) { if (PM & 16) phase4(p); }
}

extern "C" void kernel_launch(void* const* d_in, const int* in_sizes, int n_in, void* d_out, int out_size, void* d_ws, size_t ws_size, hipStream_t stream) {
  static int grid_blocks = 0;
  if (!grid_blocks) {
    int dev = 0, cus = 0, per_cu = 0;
    hipGetDevice(&dev);
    hipDeviceGetAttribute(&cus, hipDeviceAttributeMultiprocessorCount, dev);
    hipOccupancyMaxActiveBlocksPerMultiprocessor(&per_cu, mega, 256, 0);
    if (per_cu < 1) per_cu = 1;
    if (per_cu > 2) per_cu = 2;
    grid_blocks = cus * per_cu;
  }
  Params p{};
  p.x_prompt = (const float*)d_in[0]; p.x_sample = (const float*)d_in[1]; p.mem_prompt = (const float*)d_in[2];
  p.cache_diff_k = (const float*)d_in[3]; p.cache_diff_v = (const float*)d_in[4]; p.cache_mem_k = (const float*)d_in[5]; p.cache_mem_v = (const float*)d_in[6];
  p.state_gdn = (const float*)d_in[7]; p.cache_conv = (const float*)d_in[8]; p.g_pre = (const float*)d_in[9]; p.w_in = (const float*)d_in[10];
  p.conv_w = (const float*)d_in[11]; p.a_log = (const float*)d_in[12]; p.dt_bias = (const float*)d_in[13]; p.g_gdn = (const float*)d_in[14];
  p.lam_vec = (const float*)d_in[15]; p.g_sub = (const float*)d_in[16]; p.g_mem = (const float*)d_in[17]; p.w_mem_kv = (const float*)d_in[18];
  p.w_out = (const float*)d_in[19]; p.g_final = (const float*)d_in[20];
  p.out = (float*)d_out; p.ws = (char*)d_ws;
  hipMemsetAsync((char*)d_ws + OFF_CTR, 0, 8192, stream);
#if ONE_LAUNCH
  int lo = 0, hi = 5;
  void* args[] = {&p, &lo, &hi};
  hipError_t e = hipLaunchCooperativeKernel((void*)mega, dim3(grid_blocks), dim3(256), args, 0, stream);
  if (e != hipSuccess) fprintf(stderr, "cooperative launch failed: %s (grid %d)\n", hipGetErrorString(e), grid_blocks);
#else
  for (int ph = 0; ph <= 5; ++ph) hipLaunchKernelGGL(mega, dim3(grid_blocks), dim3(256), 0, stream, p, ph, ph);
#endif
}
```

```cpp
#include <hip/hip_runtime.h>
#include <hip/hip_cooperative_groups.h>
#include <cstdio>
#include <cstdint>
namespace cg = cooperative_groups;

#ifndef ONE_LAUNCH
#define ONE_LAUNCH 1
#endif

typedef __attribute__((ext_vector_type(8))) short bf16x8;
typedef __attribute__((ext_vector_type(4))) short s16x4;
typedef __attribute__((ext_vector_type(16))) float f32x16;
typedef __attribute__((ext_vector_type(2))) __bf16 bf2_t;
typedef unsigned short u16;
typedef __attribute__((ext_vector_type(4))) unsigned u32x4;
typedef __attribute__((ext_vector_type(2))) unsigned u32x2;
#define DI __device__ __forceinline__
#define MFMA(a, b, c) __builtin_amdgcn_mfma_f32_32x32x16_bf16((a), (b), (c), 0, 0, 0)

constexpr int NP = 65536;
constexpr int NS = 512;
constexpr int NT = NP + NS;
constexpr float EPSF = 1e-6f;

constexpr size_t SZ_QKV = (size_t)NT * 3072 * 2;
constexpr size_t SZ_1024 = (size_t)NT * 1024 * 2;
constexpr size_t SZ_512 = (size_t)NT * 512 * 2;
constexpr size_t OFF_QKV = 0;
constexpr size_t OFF_ZA = OFF_QKV + SZ_QKV;
constexpr size_t OFF_QB = OFF_ZA + SZ_1024;
constexpr size_t OFF_KB = OFF_QB + SZ_512;
constexpr size_t OFF_ZB = OFF_KB + SZ_512;
constexpr size_t OFF_QC = OFF_ZB + SZ_512;
constexpr size_t OFF_ZC = OFF_QC + SZ_512;
constexpr size_t OFF_VBT = OFF_ZC + SZ_512;
constexpr size_t VBT_S_EL = (size_t)8 * 4 * 128 * 8192;
constexpr size_t OFF_WINT = OFF_VBT + SZ_512;
constexpr size_t OFF_WOUTT = OFF_WINT + (size_t)7168 * 1024 * 2;
constexpr size_t OFF_WMEMT = OFF_WOUTT + (size_t)1024 * 2048 * 2;
constexpr size_t OFF_MEMN = OFF_WMEMT + (size_t)1024 * 1024 * 2;
constexpr size_t OFF_MEMK = OFF_MEMN + (size_t)2048 * 1024 * 2;
constexpr size_t OFF_MEMVT = OFF_MEMK + (size_t)2048 * 512 * 2;
constexpr size_t OFF_BA = OFF_MEMVT + (size_t)2048 * 512 * 2;
constexpr size_t OFF_GL = OFF_BA + (size_t)NT * 16 * 4;
constexpr size_t OFF_CTR = OFF_GL + (size_t)8320 * 4;
constexpr size_t WS_NEED = OFF_CTR + 8192;
constexpr size_t YO_H = 0;
constexpr size_t YO_W = 0;
constexpr size_t YO_HALO = (size_t)8320 * 8192 * 2;
constexpr size_t YO_ATT = YO_HALO + (size_t)8 * 128 * 3 * 3072 * 2;
constexpr size_t O_YP = 0;
constexpr size_t O_YS = O_YP + (size_t)NP * 1024;
constexpr size_t O_KP = O_YS + (size_t)NS * 1024;
constexpr size_t O_VP = O_KP + (size_t)NP * 512;
constexpr size_t O_MK = O_VP + (size_t)NP * 512;
constexpr size_t O_MV = O_MK + (size_t)2048 * 512;
constexpr size_t O_SP = O_MV + (size_t)2048 * 512;
constexpr size_t O_CP = O_SP + (size_t)8 * 8 * 128 * 128;
constexpr size_t O_KS = O_CP + (size_t)8 * 3 * 3072;
constexpr size_t O_VS = O_KS + (size_t)NS * 512;
constexpr size_t O_SS = O_VS + (size_t)NS * 512;
constexpr size_t O_CS = O_SS + (size_t)16 * 8 * 128 * 128;

struct Params {
  const float *x_prompt, *x_sample, *mem_prompt, *cache_diff_k, *cache_diff_v, *cache_mem_k, *cache_mem_v, *state_gdn, *cache_conv;
  const float *g_pre, *w_in, *conv_w, *a_log, *dt_bias, *g_gdn, *lam_vec, *g_sub, *g_mem, *w_mem_kv, *w_out, *g_final;
  float* out;
  char* ws;
};

__shared__ __attribute__((aligned(16))) char smem[79872];

DI unsigned pk2(float a, float b) { bf2_t v; v[0] = (__bf16)a; v[1] = (__bf16)b; return __builtin_bit_cast(unsigned, v); }
DI u16 f2bf(float a) { return __builtin_bit_cast(u16, (__bf16)a); }
DI float bf2f(u16 v) { return __uint_as_float(((unsigned)v) << 16); }
DI float bflo(unsigned v) { return __uint_as_float(v << 16); }
DI float bfhi(unsigned v) { return __uint_as_float(v & 0xffff0000u); }
DI int otid() { int t = threadIdx.x; asm volatile("" : "+v"(t)); return t; }
DI void st16_wt(void* ptr, uint4 v) { u32x4 d = {v.x, v.y, v.z, v.w}; asm volatile("global_store_dwordx4 %0, %1, off sc1\n\ts_nop 1" :: "v"(ptr), "v"(d) : "memory"); }
DI void st2_wt(void* ptr, u16 v) { unsigned d = v; asm volatile("global_store_short %0, %1, off sc1\n\ts_nop 1" :: "v"(ptr), "v"(d) : "memory"); }
DI int swap23(int k) { return (k & ~12) | ((k & 4) << 1) | ((k & 8) >> 1); }
DI int crow(int reg, int h) { return (reg & 3) + 8 * (reg >> 2) + 4 * h; }
DI float wave_sum(float v) { for (int o = 32; o > 0; o >>= 1) v += __shfl_xor(v, o); return v; }
DI float silu(float z) { return z * __builtin_amdgcn_rcpf(1.f + __expf(-z)); }
DI bf16x8 pack8(const f32x16& x, int t) {
  uint4 p; p.x = pk2(x[8 * t], x[8 * t + 1]); p.y = pk2(x[8 * t + 2], x[8 * t + 3]); p.z = pk2(x[8 * t + 4], x[8 * t + 5]); p.w = pk2(x[8 * t + 6], x[8 * t + 7]);
  return __builtin_bit_cast(bf16x8, p);
}
DI bf16x8 ld_a2(const u16* p) {
  s16x4 lo = *(const s16x4*)p; s16x4 hi = *(const s16x4*)(p + 8);
  return __builtin_shufflevector(lo, hi, 0, 1, 2, 3, 4, 5, 6, 7);
}
DI f32x16 zero16() { f32x16 z; _Pragma("unroll") for (int i = 0; i < 16; ++i) z[i] = 0.f; return z; }

DI void p0_transpose_tile(const float* src, int ld_src, int k0, int srccol0, u16* dst, int ld_dst, int n0) {
  float* t = (float*)smem;
  const int tid = otid(), r = tid >> 6, c = tid & 63;
  for (int i = 0; i < 16; ++i) { int row = r + 4 * i; t[row * 65 + c] = src[(size_t)(k0 + row) * ld_src + srccol0 + c]; }
  __syncthreads();
  for (int i = 0; i < 16; ++i) { int n = r + 4 * i; dst[(size_t)(n0 + n) * ld_dst + k0 + c] = f2bf(t[c * 65 + n]); }
  __syncthreads();
}

DI void phase0(const Params& p) {
  const int tid = otid();
  u16* WinT = (u16*)(p.ws + OFF_WINT); u16* WoutT = (u16*)(p.ws + OFF_WOUTT); u16* WmemT = (u16*)(p.ws + OFF_WMEMT);
  for (int t = blockIdx.x; t < 2560; t += gridDim.x) {
    if (t < 1792) { int kt = t / 112, nt = t % 112; int n0 = nt * 64; int sc = n0 < 4096 ? n0 : n0 + 16; p0_transpose_tile(p.w_in, 7184, kt * 64, sc, WinT, 1024, n0); }
    else if (t < 2304) { int u = t - 1792; int kt = u / 16, nt = u % 16; p0_transpose_tile(p.w_out, 1024, kt * 64, nt * 64, WoutT, 2048, nt * 64); }
    else { int u = t - 2304; int kt = u / 16, nt = u % 16; p0_transpose_tile(p.w_mem_kv, 1024, kt * 64, nt * 64, WmemT, 1024, nt * 64); }
  }
  float* wab = (float*)smem;
  __syncthreads();
  for (int i = 0; i < 64; ++i) { int idx = tid + 256 * i; int k = idx >> 4, j = idx & 15; wab[j * 1024 + k] = p.w_in[(size_t)k * 7184 + 4096 + j]; }
  __syncthreads();
  const int w = tid >> 6, lane = tid & 63;
  u16* H = (u16*)((char*)p.out + YO_H); u16* MEMN = (u16*)(p.ws + OFF_MEMN); float* BA = (float*)(p.ws + OFF_BA);
  for (int row = blockIdx.x * 4 + w; row < NT + 2048; row += gridDim.x * 4) {
    const float* src; const float* g; u16* dst;
    if (row < NP) { src = p.x_prompt + (size_t)row * 1024; g = p.g_pre; dst = H + (size_t)row * 1024; }
    else if (row < NT) { src = p.x_sample + (size_t)(row - NP) * 1024; g = p.g_pre; dst = H + (size_t)row * 1024; }
    else { src = p.mem_prompt + (size_t)(row - NT) * 1024; g = p.g_mem; dst = MEMN + (size_t)(row - NT) * 1024; }
    float4 xv[4]; float ss = 0.f;
#pragma unroll
    for (int i = 0; i < 4; ++i) { xv[i] = *(const float4*)(src + i * 256 + lane * 4); ss += xv[i].x * xv[i].x + xv[i].y * xv[i].y + xv[i].z * xv[i].z + xv[i].w * xv[i].w; }
    ss = wave_sum(ss);
    const float rstd = rsqrtf(ss * (1.f / 1024.f) + EPSF);
#pragma unroll
    for (int i = 0; i < 4; ++i) {
      float4 gv = *(const float4*)(g + i * 256 + lane * 4);
      xv[i].x *= rstd * gv.x; xv[i].y *= rstd * gv.y; xv[i].z *= rstd * gv.z; xv[i].w *= rstd * gv.w;
      uint2 o; o.x = pk2(xv[i].x, xv[i].y); o.y = pk2(xv[i].z, xv[i].w);
      *(uint2*)(dst + i * 256 + lane * 4) = o;
    }
    if (row < NT) {
      float v[16];
#pragma unroll
      for (int j = 0; j < 16; ++j) {
        float a = 0.f;
#pragma unroll
        for (int i = 0; i < 4; ++i) { float4 wv = *(const float4*)(wab + j * 1024 + i * 256 + lane * 4); a += xv[i].x * wv.x + xv[i].y * wv.y + xv[i].z * wv.z + xv[i].w * wv.w; }
        v[j] = a;
        if ((j & 3) == 3) asm volatile("" ::: "memory");
      }
      { const bool up = lane & 32;
        _Pragma("unroll") for (int t = 0; t < 8; ++t) { const float send = up ? v[t] : v[t + 8]; const float keep = up ? v[t + 8] : v[t]; v[t] = keep + __shfl_xor(send, 32); } }
      { const bool up = lane & 16;
        _Pragma("unroll") for (int t = 0; t < 4; ++t) { const float send = up ? v[t] : v[t + 4]; const float keep = up ? v[t + 4] : v[t]; v[t] = keep + __shfl_xor(send, 16); } }
      { const bool up = lane & 8;
        _Pragma("unroll") for (int t = 0; t < 2; ++t) { const float send = up ? v[t] : v[t + 2]; const float keep = up ? v[t + 2] : v[t]; v[t] = keep + __shfl_xor(send, 8); } }
      { const bool up = lane & 4; const float send = up ? v[0] : v[1]; const float keep = up ? v[1] : v[0]; v[0] = keep + __shfl_xor(send, 4); }
      v[0] += __shfl_xor(v[0], 2); v[0] += __shfl_xor(v[0], 1);
      if ((lane & 3) == 0) { const int j = ((lane >> 5) & 1) * 8 + ((lane >> 4) & 1) * 4 + ((lane >> 3) & 1) * 2 + ((lane >> 2) & 1); BA[(size_t)row * 16 + j] = v[0]; }
    }
  }
}

DI unsigned xcc_id() { return (unsigned)__builtin_amdgcn_s_getreg((3 << 11) | 20) & 7u; }
DI int xq_fetch(unsigned* q8, int per, unsigned xcc, int& steal) {
  while (steal < 8) {
    const unsigned x = (xcc + steal) & 7u;
    const int q = (int)atomicAdd(q8 + x, 1u);
    if (q < per) return (int)x * per + q;
    ++steal;
  }
  return -1;
}

struct GRegs { u32x4 a0, a1, a2, a3, b0, b1, b2, b3, b4, b5, b6, b7; };
DI void gemm_gload(GRegs& g, int kt, const u16* ap0, int ld0, const u16* ap1, int ld1, const u16* ap2, int ld2, int kt1, int kt2, const u16* Bt, int ldb) {
  const int tid = otid();
  const u16* ap; int lda; int kk;
  if (kt < kt1) { ap = ap0; lda = ld0; kk = kt; } else if (kt < kt2) { ap = ap1; lda = ld1; kk = kt - kt1; } else { ap = ap2; lda = ld2; kk = kt - kt2; }
  const int row = tid >> 3, ch = tid & 7;
  const u16* pa = ap + (unsigned)(row * lda + kk * 64 + ch * 8);
  const u16* pb = Bt + (unsigned)(row * ldb + kt * 64 + ch * 8);
  g.a0 = *(const u32x4*)(pa); g.a1 = *(const u32x4*)(pa + (unsigned)(32 * lda)); g.a2 = *(const u32x4*)(pa + (unsigned)(64 * lda)); g.a3 = *(const u32x4*)(pa + (unsigned)(96 * lda));
  g.b0 = *(const u32x4*)(pb); g.b1 = *(const u32x4*)(pb + (unsigned)(32 * ldb)); g.b2 = *(const u32x4*)(pb + (unsigned)(64 * ldb)); g.b3 = *(const u32x4*)(pb + (unsigned)(96 * ldb));
  g.b4 = *(const u32x4*)(pb + (unsigned)(128 * ldb)); g.b5 = *(const u32x4*)(pb + (unsigned)(160 * ldb)); g.b6 = *(const u32x4*)(pb + (unsigned)(192 * ldb)); g.b7 = *(const u32x4*)(pb + (unsigned)(224 * ldb));
}
DI void gemm_store(const GRegs& g, u16* As) {
  const int tid = otid(); const int srow = tid >> 3, sch = tid & 7;
  u16* pa = As + srow * 72 + sch * 8; u16* pb = pa + 128 * 72;
  *(u32x4*)(pa) = g.a0; *(u32x4*)(pa + 32 * 72) = g.a1; *(u32x4*)(pa + 64 * 72) = g.a2; *(u32x4*)(pa + 96 * 72) = g.a3;
  *(u32x4*)(pb) = g.b0; *(u32x4*)(pb + 32 * 72) = g.b1; *(u32x4*)(pb + 64 * 72) = g.b2; *(u32x4*)(pb + 96 * 72) = g.b3;
  *(u32x4*)(pb + 128 * 72) = g.b4; *(u32x4*)(pb + 160 * 72) = g.b5; *(u32x4*)(pb + 192 * 72) = g.b6; *(u32x4*)(pb + 224 * 72) = g.b7;
}
template <bool SWAP>
DI void gemm_core(const u16* ap0, int ld0, const u16* ap1, int ld1, const u16* ap2, int ld2, int kt1, int kt2, const u16* Bt, int ldb, int nk, f32x16 (&acc)[2][4]) {
  const int tid = otid(), w = tid >> 6, lane = tid & 63, r = lane & 31, h = lane >> 5, wm = w >> 1, wn = w & 1;
  const u16* As = (const u16*)smem; const u16* Bs = As + 128 * 72;
  GRegs g;
  gemm_gload(g, 0, ap0, ld0, ap1, ld1, ap2, ld2, kt1, kt2, Bt, ldb);
  __syncthreads();
  gemm_store(g, (u16*)smem);
  __syncthreads();
  for (int kt = 0; kt < nk; ++kt) {
    if (kt + 1 < nk) gemm_gload(g, kt + 1, ap0, ld0, ap1, ld1, ap2, ld2, kt1, kt2, Bt, ldb);
#pragma unroll
    for (int ks = 0; ks < 4; ++ks) {
      bf16x8 a0 = *(const bf16x8*)(As + (wm * 64 + r) * 72 + ks * 16 + h * 8);
      bf16x8 a1 = *(const bf16x8*)(As + (wm * 64 + 32 + r) * 72 + ks * 16 + h * 8);
#pragma unroll
      for (int ct = 0; ct < 4; ++ct) {
        bf16x8 b = *(const bf16x8*)(Bs + (wn * 128 + ct * 32 + r) * 72 + ks * 16 + h * 8);
        if (SWAP) { acc[0][ct] = MFMA(b, a0, acc[0][ct]); acc[1][ct] = MFMA(b, a1, acc[1][ct]); }
        else { acc[0][ct] = MFMA(a0, b, acc[0][ct]); acc[1][ct] = MFMA(a1, b, acc[1][ct]); }
      }
    }
    __syncthreads();
    if (kt + 1 < nk) { gemm_store(g, (u16*)smem); __syncthreads(); }
  }
}

DI void phase1(const Params& p) {
  const int tid = otid(), w = tid >> 6, lane = tid & 63, r = lane & 31, h = lane >> 5, wm = w >> 1, wn = w & 1;
  const u16* H = (const u16*)((const char*)p.out + YO_H);
  const u16* WinT = (const u16*)(p.ws + OFF_WINT); const u16* WmemT = (const u16*)(p.ws + OFF_WMEMT); const u16* MEMN = (const u16*)(p.ws + OFF_MEMN);
  u16* QKV = (u16*)(p.ws + OFF_QKV); u16* ZA = (u16*)(p.ws + OFF_ZA); u16* QB = (u16*)(p.ws + OFF_QB); u16* KB = (u16*)(p.ws + OFF_KB);
  u16* ZB = (u16*)(p.ws + OFF_ZB); u16* QC = (u16*)(p.ws + OFF_QC); u16* ZC = (u16*)(p.ws + OFF_ZC); u16* VBT = (u16*)(p.ws + OFF_VBT);
  u16* MEMK = (u16*)(p.ws + OFF_MEMK); u16* MEMVT = (u16*)(p.ws + OFF_MEMVT);
  u16* HALO = (u16*)((char*)p.out + YO_HALO);
  __shared__ int s_t1;
  int steal1 = 0; const unsigned xcc1 = xcc_id();
  while (true) {
    __syncthreads();
    if (otid() == 0) {
      int code = -1;
      while (steal1 < 8) {
        const unsigned x = (xcc1 + steal1) & 7u;
        const int per = 516 * (x < 4 ? 4 : 3) + 8;
        const int q = (int)atomicAdd((unsigned*)(p.ws + OFF_CTR) + 16 + x, 1u);
        if (q < per) { code = (int)x * 4096 + q; break; }
        ++steal1;
      }
      s_t1 = code;
    }
    __syncthreads();
    const int tq = __builtin_amdgcn_readfirstlane(s_t1);
    if (tq < 0) break;
    const int xq = tq >> 12, jq = tq & 4095;
    const int nown = xq < 4 ? 4 : 3, ngemm = 516 * nown;
    const int t = jq < ngemm ? 0 : 516 * 28 + xq * 8 + (jq - ngemm);
    f32x16 acc[2][4];
#pragma unroll
    for (int a = 0; a < 2; ++a)
#pragma unroll
      for (int b = 0; b < 4; ++b) acc[a][b] = zero16();
    if (t < 516 * 28) {
      const int mt = jq / nown, nt = xq + 8 * (jq % nown), m0 = mt * 128, n0 = nt * 256;
      const u16* a0 = H + (size_t)m0 * 1024;
      int grp; int cb;
      if (n0 < 3072) { grp = 0; cb = n0; } else if (n0 < 4096) { grp = 1; cb = n0 - 3072; } else { grp = 2 + (n0 - 4096) / 512; cb = (n0 - 4096) % 512; }
      const bool samp = m0 >= NP;
      if (grp == 4) {
        gemm_core<false>(a0, 1024, a0, 1024, a0, 1024, 1000, 1000, WinT + (size_t)n0 * 1024, 1024, 16, acc);
#pragma unroll
        for (int rt = 0; rt < 2; ++rt)
#pragma unroll
          for (int ct = 0; ct < 4; ++ct) {
            const int col = cb + wn * 128 + ct * 32 + r;
            const int rowb = m0 + wm * 64 + rt * 32 + 4 * h;
            const int hh = col >> 7, dv = col & 127;
#pragma unroll
            for (int q = 0; q < 4; ++q) {
              const int row = rowb + 8 * q;
              float v0 = acc[rt][ct][4 * q], v1 = acc[rt][ct][4 * q + 1], v2 = acc[rt][ct][4 * q + 2], v3 = acc[rt][ct][4 * q + 3];
              uint2 pk; pk.x = pk2(v0, v1); pk.y = pk2(v2, v3);
              if (!samp) {
                float* o = (p.out + O_VP) + (unsigned)(row * 512 + col); o[0] = v0; o[512] = v1; o[1024] = v2; o[1536] = v3;
                const int b = row >> 13, tt = row & 8191;
                *(uint2*)(VBT + (unsigned)(((b * 4 + hh) * 128 + dv) * 8192 + swap23(tt))) = pk;
              } else {
                const int rs = row - NP; float* o = (p.out + O_VS) + (unsigned)(rs * 512 + col); o[0] = v0; o[512] = v1; o[1024] = v2; o[1536] = v3;
                const int b = rs >> 5, tt = rs & 31;
                *(uint2*)((VBT + VBT_S_EL) + (unsigned)(((b * 4 + hh) * 128 + dv) * 32 + swap23(tt))) = pk;
              }
            }
          }
      } else {
        gemm_core<true>(a0, 1024, a0, 1024, a0, 1024, 1000, 1000, WinT + (size_t)n0 * 1024, 1024, 16, acc);
        u16* dst; unsigned ldd;
        switch (grp) {
          case 0: dst = QKV; ldd = 3072; break;
          case 1: dst = ZA; ldd = 1024; break;
          case 2: dst = QB; ldd = 512; break;
          case 3: dst = KB; ldd = 512; break;
          case 5: dst = ZB; ldd = 512; break;
          case 6: dst = QC; ldd = 512; break;
          default: dst = ZC; ldd = 512; break;
        }
#pragma unroll
        for (int rt = 0; rt < 2; ++rt) {
          const int row = m0 + wm * 64 + rt * 32 + r;
          int halo_row = -1, conv_row = -1;
          if (grp == 0) {
            if (!samp) {
              const int b = row >> 13, tt = row & 8191, tm = tt & 63;
              if (tm >= 61) halo_row = (b * 128 + (tt >> 6)) * 3 + tm - 61;
              if (tt >= 8189) conv_row = b * 3 + tt - 8189;
            } else {
              const int rs = row - NP, b = rs >> 5, ts = rs & 31;
              if (ts >= 29) conv_row = b * 3 + ts - 29;
            }
          }
          float* convp = p.out + (samp ? O_CS : O_CP);
          float* kout = samp ? (p.out + O_KS) + (unsigned)((row - NP) * 512) : (p.out + O_KP) + (unsigned)(row * 512);
#pragma unroll
          for (int ct = 0; ct < 4; ++ct)
#pragma unroll
            for (int q = 0; q < 4; ++q) {
              const int col = cb + wn * 128 + ct * 32 + 8 * q + 4 * h;
              const float v0 = acc[rt][ct][4 * q], v1 = acc[rt][ct][4 * q + 1], v2 = acc[rt][ct][4 * q + 2], v3 = acc[rt][ct][4 * q + 3];
              const uint2 pk = make_uint2(pk2(v0, v1), pk2(v2, v3));
              *(uint2*)(dst + (unsigned)row * ldd + col) = pk;
              if (grp == 0) {
                if (halo_row >= 0) *(uint2*)(HALO + (unsigned)(halo_row * 3072 + col)) = pk;
                if (conv_row >= 0) *(float4*)(convp + (unsigned)(conv_row * 3072 + col)) = make_float4(v0, v1, v2, v3);
              } else if (grp == 3) {
                *(float4*)(kout + col) = make_float4(v0, v1, v2, v3);
              }
            }
        }
      }
    } else {
      const int u = t - 516 * 28, mt = u / 4, nt = u % 4, m0 = mt * 128, n0 = nt * 256;
      const u16* a0 = MEMN + (size_t)m0 * 1024;
      if (n0 < 512) {
        gemm_core<true>(a0, 1024, a0, 1024, a0, 1024, 1000, 1000, WmemT + (size_t)n0 * 1024, 1024, 16, acc);
#pragma unroll
        for (int rt = 0; rt < 2; ++rt) {
          const int row = m0 + wm * 64 + rt * 32 + r;
#pragma unroll
          for (int ct = 0; ct < 4; ++ct)
#pragma unroll
            for (int q = 0; q < 4; ++q) {
              const int col = n0 + wn * 128 + ct * 32 + 8 * q + 4 * h;
              const float v0 = acc[rt][ct][4 * q], v1 = acc[rt][ct][4 * q + 1], v2 = acc[rt][ct][4 * q + 2], v3 = acc[rt][ct][4 * q + 3];
              *(float4*)((p.out + O_MK) + (unsigned)(row * 512 + col)) = make_float4(v0, v1, v2, v3);
              *(uint2*)(MEMK + (unsigned)(row * 512 + col)) = make_uint2(pk2(v0, v1), pk2(v2, v3));
            }
        }
      } else {
        gemm_core<false>(a0, 1024, a0, 1024, a0, 1024, 1000, 1000, WmemT + (size_t)n0 * 1024, 1024, 16, acc);
#pragma unroll
        for (int rt = 0; rt < 2; ++rt)
#pragma unroll
          for (int ct = 0; ct < 4; ++ct) {
            const int col = n0 + wn * 128 + ct * 32 + r;
            const int rowb = m0 + wm * 64 + rt * 32 + 4 * h;
            const int c2 = col - 512, hh = c2 >> 7, dv = c2 & 127;
#pragma unroll
            for (int q = 0; q < 4; ++q) {
              const int row = rowb + 8 * q;
              float v0 = acc[rt][ct][4 * q], v1 = acc[rt][ct][4 * q + 1], v2 = acc[rt][ct][4 * q + 2], v3 = acc[rt][ct][4 * q + 3];
              float* o = (p.out + O_MV) + (unsigned)(row * 512 + c2); o[0] = v0; o[512] = v1; o[1024] = v2; o[1536] = v3;
              uint2 pk; pk.x = pk2(v0, v1); pk.y = pk2(v2, v3);
              const int b = row >> 8, key = row & 255;
              *(uint2*)(MEMVT + (unsigned)(((b * 4 + hh) * 128 + dv) * 256 + swap23(key))) = pk;
            }
          }
      }
    }
  }
}

constexpr int KS_LD = 136, VT_LD = 72;

DI void stage_bf16(const u16* Kp, unsigned ldk, const u16* VTp, unsigned ldv, int nkeys) {
  u16* Ks = (u16*)smem; u16* Vt = Ks + 64 * KS_LD;
  const int tid = otid();
#pragma unroll
  for (int i = 0; i < 4; ++i) { int c = tid + 256 * i, row = c >> 4, ch = c & 15; if (row < nkeys) *(uint4*)(Ks + row * KS_LD + ch * 8) = *(const uint4*)(Kp + row * ldk + ch * 8); }
  for (int i = 0; i < 4; ++i) {
    int c = tid + 256 * i, row = c >> 3, ch = c & 7;
    if (ch * 8 < nkeys) *(uint4*)(Vt + row * VT_LD + ch * 8) = *(const uint4*)(VTp + row * ldv + ch * 8);
  }
}
DI void stage_f32(const float* Kp, unsigned ldk, const float* Vp, unsigned ldv) {
  u16* Ks = (u16*)smem; u16* Vt = Ks + 64 * KS_LD;
  const int tid = otid();
  for (int i = 0; i < 8; ++i) {
    int c = tid + 256 * i, row = c >> 5, ch = c & 31;
    float4 v = *(const float4*)(Kp + row * ldk + ch * 4);
    *(uint2*)(Ks + row * KS_LD + ch * 4) = make_uint2(pk2(v.x, v.y), pk2(v.z, v.w));
  }
  for (int i = 0; i < 4; ++i) {
    int u = tid + 256 * i; int q = (u & 7) + 8 * ((u >> 6) & 3), pp = ((u >> 3) & 7) + 8 * (u >> 8);
    float4 v0 = *(const float4*)(Vp + (unsigned)(2 * pp) * ldv + q * 4);
    float4 v1 = *(const float4*)(Vp + (unsigned)(2 * pp + 1) * ldv + q * 4);
    *(unsigned*)(Vt + (q * 4 + 0) * VT_LD + swap23(2 * pp)) = pk2(v0.x, v1.x);
    *(unsigned*)(Vt + (q * 4 + 1) * VT_LD + swap23(2 * pp)) = pk2(v0.y, v1.y);
    *(unsigned*)(Vt + (q * 4 + 2) * VT_LD + swap23(2 * pp)) = pk2(v0.z, v1.z);
    *(unsigned*)(Vt + (q * 4 + 3) * VT_LD + swap23(2 * pp)) = pk2(v0.w, v1.w);
  }
}

template <int NM, int KS, int NKT>
struct AttnSt { f32x16 O[NM][4]; float m[NM], l[NM]; bf16x8 qf[NM][KS]; };

template <int NM, int KS, int NKT>
DI void attn_init(AttnSt<NM, KS, NKT>& st, const u16* qrow  , int h, bool loadq = true) {
#pragma unroll
  for (int mm = 0; mm < NM; ++mm) {
#pragma unroll
    for (int d = 0; d < 4; ++d) st.O[mm][d] = zero16();
    st.m[mm] = -1e30f; st.l[mm] = 0.f;
#pragma unroll
    for (int ks = 0; ks < KS; ++ks) if (loadq) st.qf[mm][ks] = *(const bf16x8*)(qrow + mm * 64 + ks * 16 + h * 8);
  }
}

template <int NM, int KS, int NKT>
DI void attn_step(AttnSt<NM, KS, NKT>& st, const u16* Ks, int half, int dbase, float sc  ) {
  const u16* Vt = Ks + 64 * KS_LD;
  const int lane = otid() & 63, r = lane & 31, h = lane >> 5;
#pragma unroll
  for (int mm = 0; mm < NM; ++mm) {
    f32x16 s[NKT];
#pragma unroll
    for (int T = 0; T < NKT; ++T) {
      const int k0 = (NKT == 2 ? T : half) * 32;
      s[T] = zero16();
#pragma unroll
      for (int ks = 0; ks < KS; ++ks) {
        bf16x8 a = *(const bf16x8*)(Ks + (k0 + r) * KS_LD + dbase + mm * 64 + ks * 16 + h * 8);
        s[T] = MFMA(a, st.qf[mm][ks], s[T]);
      }
    }
    float mx = -1e30f;
#pragma unroll
    for (int T = 0; T < NKT; ++T)
#pragma unroll
      for (int i = 0; i < 16; ++i) mx = fmaxf(mx, s[T][i]);
    mx = fmaxf(mx, __shfl_xor(mx, 32));
    const float mxs = mx * sc;
    if (__builtin_amdgcn_ballot_w64(mxs > st.m[mm] + 8.f) != 0) {
      const float mnew = fmaxf(st.m[mm], mxs);
      const float alpha = __builtin_amdgcn_exp2f(st.m[mm] - mnew);
      st.m[mm] = mnew;
      st.l[mm] *= alpha;
#pragma unroll
      for (int d = 0; d < 4; ++d)
#pragma unroll
        for (int i = 0; i < 16; ++i) st.O[mm][d][i] *= alpha;
    }
    const float mref = st.m[mm];
    float rs = 0.f;
#pragma unroll
    for (int T = 0; T < NKT; ++T)
#pragma unroll
      for (int i = 0; i < 16; ++i) { float pv = __builtin_amdgcn_exp2f(s[T][i] * sc - mref); s[T][i] = pv; rs += pv; }
    st.l[mm] += rs;
#pragma unroll
    for (int T = 0; T < NKT; ++T) {
      const int k0 = (NKT == 2 ? T : half) * 32;
#pragma unroll
      for (int t = 0; t < 2; ++t) {
        if (NM > 1) asm volatile("" ::: "memory");
        bf16x8 pb = pack8(s[T], t);
#pragma unroll
        for (int d = 0; d < 4; ++d) {
          bf16x8 a = *(const bf16x8*)(Vt + (d * 32 + r) * VT_LD + k0 + 16 * t + 8 * h);
          st.O[mm][d] = MFMA(a, pb, st.O[mm][d]);
        }
      }
    }
  }
}

struct KVRegs { u32x4 k0, k1, k2, k3, v0, v1, v2, v3; };
DI void kv_load(KVRegs& g, const u16* Kp, unsigned ldk, const u16* VTp, unsigned ldv) {
  const int tid = otid();
  const int krow = tid >> 4, kch = tid & 15, vrow = tid >> 3, vch = tid & 7;
  const u16* pk = Kp + (unsigned)(krow * ldk + kch * 8);
  g.k0 = *(const u32x4*)pk; g.k1 = *(const u32x4*)(pk + 16 * ldk); g.k2 = *(const u32x4*)(pk + 32 * ldk); g.k3 = *(const u32x4*)(pk + 48 * ldk);
  const u16* pv = VTp + (unsigned)(vrow * ldv + vch * 8);
  g.v0 = *(const u32x4*)pv; g.v1 = *(const u32x4*)(pv + 32 * ldv); g.v2 = *(const u32x4*)(pv + 64 * ldv); g.v3 = *(const u32x4*)(pv + 96 * ldv);
}
DI void kv_store(const KVRegs& g, u16* Ks) {
  const int tid = otid();
  const int krow = tid >> 4, kch = tid & 15, vrow = tid >> 3, vch = tid & 7;
  u16* pk = Ks + krow * KS_LD + kch * 8;
  *(u32x4*)pk = g.k0; *(u32x4*)(pk + 16 * KS_LD) = g.k1; *(u32x4*)(pk + 32 * KS_LD) = g.k2; *(u32x4*)(pk + 48 * KS_LD) = g.k3;
  u16* pv = Ks + 64 * KS_LD + vrow * VT_LD + vch * 8;
  *(u32x4*)pv = g.v0; *(u32x4*)(pv + 32 * VT_LD) = g.v1; *(u32x4*)(pv + 64 * VT_LD) = g.v2; *(u32x4*)(pv + 96 * VT_LD) = g.v3;
}
constexpr int KVBUF = 64 * KS_LD + 128 * VT_LD;

DI float lam_value(const Params& p) {
  float s0 = 0.f, s1 = 0.f;
#pragma unroll 1
  for (int i = 0; i < 64; ++i) { s0 += p.lam_vec[i] * p.lam_vec[64 + i]; s1 += p.lam_vec[128 + i] * p.lam_vec[192 + i]; }
  return __expf(s0) - __expf(s1) + 0.2f;
}

DI void epi_diff(const Params& p, f32x16 (&o)[4], unsigned tok, int hh, int h) {
  float ss = 0.f;
#pragma unroll
  for (int d = 0; d < 4; ++d)
#pragma unroll
    for (int i = 0; i < 16; ++i) ss += o[d][i] * o[d][i];
  ss += __shfl_xor(ss, 32);
  const float rstd = rsqrtf(ss * (1.f / 128.f) + EPSF) * 0.8f;
  const u16* ZB = (const u16*)(p.ws + OFF_ZB); u16* MIXB = (u16*)(p.ws + OFF_QB);
#pragma unroll
  for (int d = 0; d < 4; ++d)
#pragma unroll
    for (int q = 0; q < 4; ++q) {
      if ((q & 1) == 0) asm volatile("" ::: "memory");
      const int dv = d * 32 + 8 * q + 4 * h;
      const uint2 zz = *(const uint2*)(ZB + tok * 512 + hh * 128 + dv);
      const float4 gg = *(const float4*)(p.g_sub + dv);
      float v0 = o[d][4 * q] * rstd * gg.x * silu(bflo(zz.x)), v1 = o[d][4 * q + 1] * rstd * gg.y * silu(bfhi(zz.x));
      float v2 = o[d][4 * q + 2] * rstd * gg.z * silu(bflo(zz.y)), v3 = o[d][4 * q + 3] * rstd * gg.w * silu(bfhi(zz.y));
      *(uint2*)(MIXB + tok * 512 + hh * 128 + dv) = make_uint2(pk2(v0, v1), pk2(v2, v3));
    }
}
DI void epi_mem(const Params& p, f32x16 (&o)[4], unsigned tok, int hh, int h) {
  const u16* ZC = (const u16*)(p.ws + OFF_ZC); u16* MIXC = (u16*)(p.ws + OFF_QC);
#pragma unroll
  for (int d = 0; d < 4; ++d)
#pragma unroll
    for (int q = 0; q < 4; ++q) {
      if ((q & 1) == 0) asm volatile("" ::: "memory");
      const int dv = d * 32 + 8 * q + 4 * h;
      const uint2 zz = *(const uint2*)(ZC + tok * 512 + hh * 128 + dv);
      float v0 = o[d][4 * q] * silu(bflo(zz.x)), v1 = o[d][4 * q + 1] * silu(bfhi(zz.x));
      float v2 = o[d][4 * q + 2] * silu(bflo(zz.y)), v3 = o[d][4 * q + 3] * silu(bfhi(zz.y));
      *(uint2*)(MIXC + tok * 512 + hh * 128 + dv) = make_uint2(pk2(v0, v1), pk2(v2, v3));
    }
}

constexpr float LOG2E = 1.4426950408889634f;

DI void attn_b_prompt(const Params& p, int bh, int c) {
  const int tid = otid(), w = tid >> 6, lane = tid & 63, r = lane & 31, h = lane >> 5;
  const int b = bh >> 2, hh = bh & 3, map = w >> 1, qsub = w & 1;
  const u16* QB = (const u16*)(p.ws + OFF_QB); const u16* KB = (const u16*)(p.ws + OFF_KB); const u16* VBT = (const u16*)(p.ws + OFF_VBT);
  const unsigned tok = (unsigned)b * 8192 + c * 64 + qsub * 32 + r;
  AttnSt<1, 4, 2> st;
  attn_init(st, QB + tok * 512 + hh * 128 + map * 64, h);
  const int ntiles = c + 1;
  const float sc = 0.125f * LOG2E;
  const u16* Kbase = KB + ((size_t)b * 8192) * 512 + hh * 128; const u16* VTbase = VBT + ((size_t)(b * 4 + hh) * 128) * 8192;
  KVRegs g;
  kv_load(g, Kbase, 512, VTbase, 8192);
  __syncthreads();
  kv_store(g, (u16*)smem);
  __syncthreads();
  for (int kt = 0; kt < ntiles; ++kt) {
    if (kt + 1 < ntiles) kv_load(g, Kbase + (unsigned)((kt + 1) * 64 * 512), 512, VTbase + (kt + 1) * 64, 8192);
    attn_step<1, 4, 2>(st, (const u16*)smem + (kt & 1) * KVBUF, 0, map * 64, sc);
    if (kt + 1 < ntiles) kv_store(g, (u16*)smem + ((kt + 1) & 1) * KVBUF);
    __syncthreads();
  }
  const float lam = lam_value(p);
  const float l = st.l[0] + __shfl_xor(st.l[0], 32);
  const float inv = (map == 0 ? 1.f : lam) / l;
#pragma unroll
  for (int d = 0; d < 4; ++d)
#pragma unroll
    for (int i = 0; i < 16; ++i) st.O[0][d][i] *= inv;
  float* slot = (float*)smem + qsub * 4096;
  if (map == 1) {
#pragma unroll
    for (int d = 0; d < 4; ++d)
#pragma unroll
      for (int i = 0; i < 16; ++i) slot[(d * 16 + i) * 64 + lane] = st.O[0][d][i];
  }
  __syncthreads();
  if (map == 0) {
#pragma unroll
    for (int d = 0; d < 4; ++d)
#pragma unroll
      for (int i = 0; i < 16; ++i) st.O[0][d][i] -= slot[(d * 16 + i) * 64 + lane];
    epi_diff(p, st.O[0], tok, hh, h);
  }
  __syncthreads();
}

DI void attn_step2q(AttnSt<2, 4, 2>& st, const u16* Ks, const u16* Qs, float sc) {
  const u16* Vt = Ks + 64 * KS_LD;
  const int tid = otid(), lane = tid & 63, r = lane & 31, h = lane >> 5, wq = tid >> 6;
#pragma unroll
  for (int T = 0; T < 2; ++T) {
    asm volatile("" ::: "memory");
    f32x16 s[2];
#pragma unroll
    for (int mm = 0; mm < 2; ++mm) {
      s[mm] = zero16();
#pragma unroll
      for (int ks = 0; ks < 4; ++ks) {
        bf16x8 a = *(const bf16x8*)(Ks + (T * 32 + r) * KS_LD + mm * 64 + ks * 16 + h * 8);
        bf16x8 q = *(const bf16x8*)(Qs + (wq * 32 + r) * 136 + mm * 64 + ks * 16 + h * 8);
        s[mm] = MFMA(a, q, s[mm]);
      }
    }
#pragma unroll
    for (int mm = 0; mm < 2; ++mm) {
      float mx = -1e30f;
#pragma unroll
      for (int i = 0; i < 16; ++i) mx = fmaxf(mx, s[mm][i]);
      mx = fmaxf(mx, __shfl_xor(mx, 32));
      const float mxs = mx * sc;
      if (__builtin_amdgcn_ballot_w64(mxs > st.m[mm] + 8.f) != 0) {
        const float mnew = fmaxf(st.m[mm], mxs);
        const float alpha = __builtin_amdgcn_exp2f(st.m[mm] - mnew);
        st.m[mm] = mnew; st.l[mm] *= alpha;
#pragma unroll
        for (int d = 0; d < 4; ++d)
#pragma unroll
          for (int i = 0; i < 16; ++i) st.O[mm][d][i] *= alpha;
      }
      const float mref = st.m[mm];
      float rs = 0.f;
#pragma unroll
      for (int i = 0; i < 16; ++i) { float pv = __builtin_amdgcn_exp2f(s[mm][i] * sc - mref); s[mm][i] = pv; rs += pv; }
      st.l[mm] += rs;
    }
#pragma unroll
    for (int t = 0; t < 2; ++t) {
      asm volatile("" ::: "memory");
      const bf16x8 pb0 = pack8(s[0], t), pb1 = pack8(s[1], t);
#pragma unroll
      for (int d = 0; d < 4; ++d) {
        bf16x8 a = *(const bf16x8*)(Vt + (d * 32 + r) * VT_LD + T * 32 + 16 * t + 8 * h);
        st.O[0][d] = MFMA(a, pb0, st.O[0][d]);
        st.O[1][d] = MFMA(a, pb1, st.O[1][d]);
      }
    }
  }
}
DI void attn_b_prompt2(const Params& p, int bh, int j) {
  const int b = bh >> 2, hh = bh & 3;
  const u16* QB = (const u16*)(p.ws + OFF_QB); const u16* KB = (const u16*)(p.ws + OFF_KB); const u16* VBT = (const u16*)(p.ws + OFF_VBT);
  AttnSt<2, 4, 2> st;
  attn_init(st, QB, 0, false);
  const int ntiles = 2 * j + 2;
  const float sc = 0.125f * LOG2E;
  const u16* Kbase = KB + ((size_t)b * 8192) * 512 + hh * 128; const u16* VTbase = VBT + ((size_t)(b * 4 + hh) * 128) * 8192;
  u16* Qs = (u16*)smem + KVBUF;
  KVRegs g;
  kv_load(g, Kbase, 512, VTbase, 8192);
  __syncthreads();
  {
    const int tid = otid();
    const u16* qsrc = QB + ((unsigned)b * 8192 + j * 128) * 512 + hh * 128;
#pragma unroll
    for (int i = 0; i < 8; ++i) { const int c = tid + 256 * i, row = c >> 4, ch = c & 15; *(uint4*)(Qs + row * 136 + ch * 8) = *(const uint4*)(qsrc + (unsigned)row * 512 + ch * 8); }
  }
  kv_store(g, (u16*)smem);
  __syncthreads();
  for (int kt = 0; kt < ntiles; ++kt) {
    if (kt + 1 < ntiles) kv_load(g, Kbase + (unsigned)((kt + 1) * 64 * 512), 512, VTbase + (kt + 1) * 64, 8192);
    if (kt < ntiles - 1 || (otid() >> 6) >= 2) attn_step2q(st, (const u16*)smem, Qs, sc);
    __syncthreads();
    if (kt + 1 < ntiles) { kv_store(g, (u16*)smem); __syncthreads(); }
  }
  const float lam = lam_value(p);
  const float l0 = st.l[0] + __shfl_xor(st.l[0], 32), l1 = st.l[1] + __shfl_xor(st.l[1], 32);
  const float i0 = 1.f / l0, i1 = lam / l1;
#pragma unroll
  for (int d = 0; d < 4; ++d)
#pragma unroll
    for (int i = 0; i < 16; ++i) st.O[0][d][i] = st.O[0][d][i] * i0 - st.O[1][d][i] * i1;
  const int tid = otid(), w = tid >> 6, lane = tid & 63, r = lane & 31, h = lane >> 5;
  const unsigned tok = (unsigned)b * 8192 + j * 128 + w * 32 + r;
  epi_diff(p, st.O[0], tok, hh, h);
}

DI void attn_c_prompt(const Params& p, int qt, int hh) {
  const int tid = otid(), w = tid >> 6, lane = tid & 63, r = lane & 31, h = lane >> 5;
  const u16* QC = (const u16*)(p.ws + OFF_QC); const u16* MEMK = (const u16*)(p.ws + OFF_MEMK); const u16* MEMVT = (const u16*)(p.ws + OFF_MEMVT);
  const unsigned tok = (unsigned)qt * 128 + w * 32 + r;
  const int b = qt >> 6;
  AttnSt<1, 8, 2> st;
  attn_init(st, QC + tok * 512 + hh * 128, h);
  const float sc = 0.08838834764831845f * LOG2E;
  const u16* Kbase = MEMK + ((size_t)b * 256) * 512 + hh * 128; const u16* VTbase = MEMVT + ((size_t)(b * 4 + hh) * 128) * 256;
  KVRegs g;
  kv_load(g, Kbase, 512, VTbase, 256);
  __syncthreads();
  kv_store(g, (u16*)smem);
  __syncthreads();
  for (int kt = 0; kt < 4; ++kt) {
    if (kt + 1 < 4) kv_load(g, Kbase + (unsigned)((kt + 1) * 64 * 512), 512, VTbase + (kt + 1) * 64, 256);
    attn_step<1, 8, 2>(st, (const u16*)smem + (kt & 1) * KVBUF, 0, 0, sc);
    if (kt + 1 < 4) kv_store(g, (u16*)smem + ((kt + 1) & 1) * KVBUF);
    __syncthreads();
  }
  float l0 = st.l[0] + __shfl_xor(st.l[0], 32);
  const float i0 = 1.f / l0;
#pragma unroll
  for (int d = 0; d < 4; ++d)
#pragma unroll
    for (int i = 0; i < 16; ++i) st.O[0][d][i] *= i0;
  epi_mem(p, st.O[0], tok, hh, h);
}

template <bool DIFF>
DI void attn_sample(const Params& p, int b, int hh) {
  const int tid = otid(), w = tid >> 6, lane = tid & 63, r = lane & 31, h = lane >> 5;
  const int map = w >> 1, half = w & 1;
  const bool active = DIFF || map == 0;
  const unsigned tok = (unsigned)NP + b * 32 + r;
  constexpr int KSN = DIFF ? 4 : 8;
  AttnSt<1, KSN, 1> st;
  const u16* Q = (const u16*)(p.ws + (DIFF ? OFF_QB : OFF_QC));
  attn_init(st, Q + tok * 512 + hh * 128 + (DIFF ? map * 64 : 0), h);
  const float sc = (DIFF ? 0.125f : 0.08838834764831845f) * LOG2E;
  const int dbase = DIFF ? map * 64 : 0;
  const int ncache = DIFF ? 64 : 4;
  const float* Kc = DIFF ? p.cache_diff_k : p.cache_mem_k; const float* Vc = DIFF ? p.cache_diff_v : p.cache_mem_v;
  const size_t T = DIFF ? 4096 : 256;
  for (int kt = 0; kt < ncache; ++kt) {
    __syncthreads();
    stage_f32(Kc + ((size_t)b * T + kt * 64) * 512 + hh * 128, 512, Vc + ((size_t)b * T + kt * 64) * 512 + hh * 128, 512);
    __syncthreads();
    if (active) attn_step<1, KSN, 1>(st, (const u16*)smem, half, dbase, sc);
  }
  if (DIFF) {
    const u16* KB = (const u16*)(p.ws + OFF_KB); const u16* VBT = (const u16*)(p.ws + OFF_VBT);
    __syncthreads();
    stage_bf16(KB + ((size_t)NP + b * 32) * 512 + hh * 128, 512, VBT + VBT_S_EL + ((size_t)(b * 4 + hh) * 128) * 32, 32, 32);
    __syncthreads();
    if (half == 0) attn_step<1, KSN, 1>(st, (const u16*)smem, 0, dbase, sc);
  }
  float* slot = (float*)smem + map * (64 * 64 + 128);
  __syncthreads();
  if (active && half == 1) {
#pragma unroll
    for (int d = 0; d < 4; ++d)
#pragma unroll
      for (int i = 0; i < 16; ++i) slot[(d * 16 + i) * 64 + lane] = st.O[0][d][i];
    slot[4096 + lane] = st.m[0]; slot[4160 + lane] = st.l[0];
  }
  __syncthreads();
  if (active && half == 0) {
    const float m2 = slot[4096 + lane], l2 = slot[4160 + lane];
    const float mn = fmaxf(st.m[0], m2), a1 = exp2f(st.m[0] - mn), a2 = exp2f(m2 - mn);
    float l = st.l[0] * a1 + l2 * a2;
    l += __shfl_xor(l, 32);
    const float inv = 1.f / l;
#pragma unroll
    for (int d = 0; d < 4; ++d)
#pragma unroll
      for (int i = 0; i < 16; ++i) st.O[0][d][i] = (st.O[0][d][i] * a1 + slot[(d * 16 + i) * 64 + lane] * a2) * inv;
  }
  __syncthreads();
  if (DIFF) {
    float* s0 = (float*)smem;
    if (w == 2) {
#pragma unroll
      for (int d = 0; d < 4; ++d)
#pragma unroll
        for (int i = 0; i < 16; ++i) s0[(d * 16 + i) * 64 + lane] = st.O[0][d][i];
    }
    __syncthreads();
    if (w == 0) {
      const float lam = lam_value(p);
#pragma unroll
      for (int d = 0; d < 4; ++d)
#pragma unroll
        for (int i = 0; i < 16; ++i) st.O[0][d][i] -= lam * s0[(d * 16 + i) * 64 + lane];
      epi_diff(p, st.O[0], tok, hh, h);
    }
  } else {
    if (w == 0) epi_mem(p, st.O[0], tok, hh, h);
  }
  __syncthreads();
}

DI size_t wbuf_off(int task) { return task < 8192 ? (size_t)task * 8192 : (size_t)8192 * 8192 + (size_t)(task - 8192) * 4096; }
DI size_t att_off(int task) { return task < 8192 ? (size_t)task * 4096 : (size_t)8192 * 4096 + (size_t)(task - 8192) * 1024; }

template <int C>
DI void g1_task(const Params& p, int task) {
  constexpr bool SAMPLE = (C == 32);
  const int tid = otid(), w = tid >> 6, lane = tid & 63, r = lane & 31, h = lane >> 5;
  int b, n, hh;
  if (!SAMPLE) { hh = task & 7; n = (task >> 3) & 127; b = task >> 10; } else { int u = task - 8192; hh = u & 7; b = u >> 3; n = 0; }
  const unsigned tok0 = SAMPLE ? (unsigned)NP + b * 32 : (unsigned)b * 8192 + n * 64;
  u16* qs = (u16*)smem; u16* ks = qs + 64 * 136; u16* raw = ks + 64 * 136;
  float* Lf = (float*)smem;
  float* fG = (float*)(smem + 51968); float* fB = fG + 64; float* fE = fB + 64;
  u16* QKV = (u16*)(p.ws + OFF_QKV);
  const u16* HALO = (const u16*)((const char*)p.out + YO_HALO);
  u16* WBUF = (u16*)((char*)p.out + YO_W); u16* ATT = (u16*)((char*)p.out + YO_ATT);
  const float* BA = (const float*)(p.ws + OFF_BA); float* GL = (float*)(p.ws + OFF_GL);

  float* fD = fE + 64;
  float* cw = (float*)(smem + 52736 + 256);
  float bb_in = 0.f, aa_in = 0.f;
  if (w == 0 && lane < C) { bb_in = BA[(tok0 + lane) * 16 + hh]; aa_in = BA[(tok0 + lane) * 16 + 8 + hh]; }
  for (int idx = tid; idx < 384; idx += 256) {
    const int rw_ = idx >> 5, c4 = idx & 31, sec = rw_ >> 2, tap = rw_ & 3;
    *(float4*)(cw + rw_ * 128 + c4 * 4) = *(const float4*)(p.conv_w + (unsigned)(tap * 3072 + sec * 1024 + hh * 128 + c4 * 4));
  }
  if (w == 0) {
    float g = 0.f, beta = 0.f;
    if (lane < C) {
      const float bb = bb_in, aa = aa_in;
      beta = 1.f / (1.f + __expf(-bb));
      const float xx = aa + p.dt_bias[hh];
      const float sp = xx > 20.f ? xx : log1pf(__expf(xx));
      g = -__expf(p.a_log[hh]) * sp;
    }
    for (int d = 1; d < 64; d <<= 1) { float t = __shfl_up(g, d); if (lane >= d) g += t; }
    const float glast = __shfl(g, C - 1);
    if (lane < C) { fG[lane] = g; fB[lane] = beta; fE[lane] = __expf(g); fD[lane] = __expf(glast - g); }
  }
  __syncthreads();
  const int crow_ = tid >> 2, cq = tid & 3;
  if (crow_ < C) {
#pragma unroll 1
    for (int sec = 0; sec < 3; ++sec) {
      const int colg = sec * 1024 + hh * 128;
      float y[32]; float ss = 0.f;
#pragma unroll
      for (int c8 = 0; c8 < 4; ++c8) {
        const int col = cq * 32 + c8 * 8;
        uint4 xv[4];
#pragma unroll
        for (int i = 0; i < 4; ++i) {
          const int rr = crow_ + i;
          if (rr >= 3) xv[i] = *(const uint4*)(QKV + (tok0 + rr - 3) * 3072 + colg + col);
          else if (SAMPLE) {
            const float* cc = p.cache_conv + ((size_t)b * 3 + rr) * 3072 + colg + col;
            const float4 a = *(const float4*)cc, bq = *(const float4*)(cc + 4);
            xv[i] = make_uint4(pk2(a.x, a.y), pk2(a.z, a.w), pk2(bq.x, bq.y), pk2(bq.z, bq.w));
          } else if (n == 0) xv[i] = make_uint4(0, 0, 0, 0);
          else xv[i] = *(const uint4*)(HALO + ((size_t)((b * 128 + n - 1) * 3 + rr)) * 3072 + colg + col);
        }
        float acc8[8];
#pragma unroll
        for (int e = 0; e < 8; ++e) acc8[e] = 0.f;
#pragma unroll
        for (int i = 0; i < 4; ++i) {
          const float4 w0 = *(const float4*)(cw + (sec * 4 + i) * 128 + col), w1 = *(const float4*)(cw + (sec * 4 + i) * 128 + col + 4);
          acc8[0] += bflo(xv[i].x) * w0.x; acc8[1] += bfhi(xv[i].x) * w0.y; acc8[2] += bflo(xv[i].y) * w0.z; acc8[3] += bfhi(xv[i].y) * w0.w;
          acc8[4] += bflo(xv[i].z) * w1.x; acc8[5] += bfhi(xv[i].z) * w1.y; acc8[6] += bflo(xv[i].w) * w1.z; acc8[7] += bfhi(xv[i].w) * w1.w;
        }
#pragma unroll
        for (int e = 0; e < 8; ++e) { float v = silu(acc8[e]); y[c8 * 8 + e] = v; ss += v * v; }
      }
      float sc = 1.f;
      if (sec < 2) {
        ss += __shfl_xor(ss, 1); ss += __shfl_xor(ss, 2);
        sc = rsqrtf(ss + EPSF) * (sec == 0 ? 0.08838834764831845f : 1.f);
      }
      u16* dst = sec == 0 ? qs + crow_ * 136 + cq * 32 : (sec == 1 ? ks + crow_ * 136 + cq * 32 : raw + crow_ * 128 + cq * 32);
#pragma unroll
      for (int c8 = 0; c8 < 4; ++c8)
        *(uint4*)(dst + c8 * 8) = make_uint4(pk2(y[c8 * 8] * sc, y[c8 * 8 + 1] * sc), pk2(y[c8 * 8 + 2] * sc, y[c8 * 8 + 3] * sc), pk2(y[c8 * 8 + 4] * sc, y[c8 * 8 + 5] * sc), pk2(y[c8 * 8 + 6] * sc, y[c8 * 8 + 7] * sc));
    }
  }
  __syncthreads();
  const u16* vs = raw;
  const int ri = w >> 1, ci = w & 1;
  const bool act = SAMPLE ? (w == 0) : true;
  const bool lower = act && (ri >= ci);
  f32x16 kk = zero16(), qk = zero16();
  if (lower) {
#pragma unroll
    for (int s = 0; s < 8; ++s) {
      bf16x8 bk = *(const bf16x8*)(ks + (ci * 32 + r) * 136 + s * 16 + h * 8);
      bf16x8 ak = *(const bf16x8*)(ks + (ri * 32 + r) * 136 + s * 16 + h * 8);
      bf16x8 aq = *(const bf16x8*)(qs + (ri * 32 + r) * 136 + s * 16 + h * 8);
      kk = MFMA(ak, bk, kk); qk = MFMA(aq, bk, qk);
    }
  }
  __syncthreads();
  for (int idx = tid; idx < C * 16; idx += 256) {
    const int row = idx >> 4, ch = idx & 15;
    const uint4 v = *(const uint4*)(qs + row * 136 + ch * 8);
    const float e = fE[row];
    st16_wt(QKV + (tok0 + row) * 3072 + hh * 128 + ch * 8,
            make_uint4(pk2(bflo(v.x) * e, bfhi(v.x) * e), pk2(bflo(v.y) * e, bfhi(v.y) * e), pk2(bflo(v.z) * e, bfhi(v.z) * e), pk2(bflo(v.w) * e, bfhi(v.w) * e)));
  }
  {
    const float gl = fG[C - 1];
    for (int idx = tid; idx < 16 * C; idx += 256) {
      const int dk = idx & 127, c0 = (idx >> 7) * 8;
      float v[8];
#pragma unroll
      for (int j = 0; j < 8; ++j) v[j] = bf2f(ks[(c0 + j) * 136 + dk]) * fD[c0 + j];
      const int flat = dk * C + c0;
      const uint4 ov = make_uint4(pk2(v[0], v[1]), pk2(v[2], v[3]), pk2(v[4], v[5]), pk2(v[6], v[7]));
      st16_wt(QKV + (tok0 + (flat >> 7)) * 3072 + 1024 + hh * 128 + (flat & 127), ov);
    }
    if (tid == 0) __hip_atomic_store((unsigned*)GL + task, __float_as_uint(__expf(gl)), __ATOMIC_RELAXED, __HIP_MEMORY_SCOPE_AGENT);
  }
  __syncthreads();
  float* LT = (float*)smem;
  if (act) {
    const int col = ci * 32 + r;
    const float gc = fG[col];
#pragma unroll
    for (int i = 0; i < 16; ++i) {
      const int row = ri * 32 + crow(i, h);
      const float dec = __expf(fminf(fG[row] - gc, 0.f));
      if (lower) LT[col * 68 + row] = row > col ? fB[row] * kk[i] * dec : 0.f;
      st2_wt(ATT + att_off(task) + row * C + col, f2bf(row >= col ? qk[i] * dec : 0.f));
    }
  }
  __syncthreads();
  {
    const int cc = tid & 127; const bool isU = tid < 128;
    u16* X = isU ? (raw + cc) : (ks + cc);
    const int ld = isU ? 128 : 136;
#pragma unroll 1
    for (int ib = 0; ib < C / 8; ++ib) {
      float a[8];
#pragma unroll
      for (int ii = 0; ii < 8; ++ii) { const int i = ib * 8 + ii; a[ii] = bf2f(X[i * ld]) * (isU ? fB[i] : fB[i] * fE[i]); }
#pragma unroll 2
      for (int j = 0; j < ib * 8; ++j) {
        const float xj = bf2f(X[j * ld]);
        const float4 l0 = *(const float4*)(LT + j * 68 + ib * 8), l1 = *(const float4*)(LT + j * 68 + ib * 8 + 4);
        a[0] -= l0.x * xj; a[1] -= l0.y * xj; a[2] -= l0.z * xj; a[3] -= l0.w * xj;
        a[4] -= l1.x * xj; a[5] -= l1.y * xj; a[6] -= l1.z * xj; a[7] -= l1.w * xj;
      }
#pragma unroll
      for (int ii = 1; ii < 8; ++ii)
#pragma unroll
        for (int jj = 0; jj < ii; ++jj) a[ii] -= LT[(ib * 8 + jj) * 68 + ib * 8 + ii] * a[jj];
#pragma unroll
      for (int ii = 0; ii < 8; ++ii) X[(ib * 8 + ii) * ld] = f2bf(a[ii]);
    }
  }
  __syncthreads();
  {
    u16* wd = WBUF + wbuf_off(task);
    for (int idx = tid; idx < C * 16; idx += 256) {
      const int row = idx >> 4, ch = idx & 15;
      st16_wt(QKV + (tok0 + row) * 3072 + 2048 + hh * 128 + ch * 8, *(const uint4*)(raw + row * 128 + ch * 8));
      st16_wt(wd + row * 128 + ch * 8, *(const uint4*)(ks + row * 136 + ch * 8));
    }
  }
  asm volatile("s_waitcnt vmcnt(0)" ::: "memory");
  __syncthreads();
  if (tid == 0) {
    unsigned* cnt = (unsigned*)(p.ws + OFF_CTR) + 64 + (SAMPLE ? 512 + b * 8 + hh : (b * 8 + hh) * 8 + (n >> 4));
    __hip_atomic_fetch_add(cnt, 1u, __ATOMIC_RELAXED, __HIP_MEMORY_SCOPE_AGENT);
  }
  __syncthreads();
}

template <int RT>
DI void scan_task(const Params& p, int b, int hh) {
  constexpr int C = 32 * RT; constexpr bool SAMPLE = (RT == 1);
  constexpr int NI = C / 16, NA = (C == 64) ? 2 : 1;
  const int tid = otid(), w = tid >> 6, lane = tid & 63, r = lane & 31, h = lane >> 5;
  u16* wsm = (u16*)smem; u16* us = wsm + 64 * 136; u16* qds = us + 64 * 136; u16* kts = qds + 64 * 136; u16* asm_ = kts + 128 * 72;
  u16* QKV = (u16*)(p.ws + OFF_QKV);
  const u16* WBUF = (const u16*)((const char*)p.out + YO_W); const u16* ATT = (const u16*)((const char*)p.out + YO_ATT);
  const float* GL = (const float*)(p.ws + OFF_GL);
  f32x16 S[4];
  if (SAMPLE) {
#pragma unroll
    for (int d = 0; d < 4; ++d)
#pragma unroll
      for (int i = 0; i < 16; ++i) {
        const float* srow = p.state_gdn + (size_t)(b * 8 + hh) * 128 * 128 + (d * 32 + (i & 3) + 8 * (i >> 2)) * 128;
        S[d][i] = srow[(unsigned)(4 * h * 128 + w * 32 + r)];
      }
  } else {
#pragma unroll
    for (int d = 0; d < 4; ++d) S[d] = zero16();
  }
  const int nchunks = SAMPLE ? 1 : 128;
  auto wait_group = [&](int grp) {
    if (otid() == 0) {
      unsigned* cnt = (unsigned*)(p.ws + OFF_CTR) + 64 + (SAMPLE ? 512 + b * 8 + hh : (b * 8 + hh) * 8 + grp);
      const unsigned need = SAMPLE ? 1u : 16u;
      while (__hip_atomic_load(cnt, __ATOMIC_RELAXED, __HIP_MEMORY_SCOPE_AGENT) < need) __builtin_amdgcn_s_sleep(16);
      __builtin_amdgcn_fence(__ATOMIC_ACQUIRE, "agent");
      asm volatile("s_waitcnt vmcnt(0)" ::: "memory");
    }
    __syncthreads();
  };
  wait_group(0);
  u32x4 rw[NI], ru[NI], rq[NI], rk[NI], ra[NA];
  auto task_of = [&](int n) { return SAMPLE ? 8192 + b * 8 + hh : (b * 128 + n) * 8 + hh; };
  auto tok_of = [&](int n) { return SAMPLE ? (unsigned)NP + b * 32 : (unsigned)b * 8192 + n * 64; };
#define SCAN_LOAD1(n_)                                                                                   \
  {                                                                                                      \
    const int tid = otid();                                                            \
    const u16* wsrc = WBUF + wbuf_off(task_of(n_)); const unsigned tk = tok_of(n_);                      \
    const unsigned lo_w = (unsigned)((tid >> 4) * 128 + (tid & 15) * 8), lo_q = (unsigned)((tid >> 4) * 3072 + (tid & 15) * 8); \
    _Pragma("unroll") for (int i = 0; i < NI; ++i) {                                                     \
      const u16* qb_ = QKV + (size_t)(tk + 16 * i) * 3072 + hh * 128;                         \
      rw[i] = *(const u32x4*)((wsrc + 16 * i * 128) + lo_w);                                             \
      ru[i] = *(const u32x4*)((qb_ + 2048) + lo_q);                                                      \
    }                                                                                                    \
  }
#define SCAN_STORE1()                                                                                    \
  {                                                                                                      \
    const int tid = otid();                                                            \
    _Pragma("unroll") for (int i = 0; i < NI; ++i) {                                                     \
      const int idx = tid + 256 * i, row = idx >> 4, ch = idx & 15;                                      \
      *(u32x4*)(wsm + row * 136 + ch * 8) = rw[i]; *(u32x4*)(us + row * 136 + ch * 8) = ru[i];           \
    }                                                                                                    \
  }
#define SCAN_LOAD2(n_)                                                                                   \
  {                                                                                                      \
    const int tid = otid();                                                            \
    const u16* asrc = ATT + att_off(task_of(n_)); const unsigned tk = tok_of(n_);                        \
    const unsigned lo_k = (unsigned)((tid >> 4) * 3072 + (tid & 15) * 8);                                \
    _Pragma("unroll") for (int i = 0; i < NI; ++i) {                                                     \
      const u16* qb_ = QKV + (size_t)(tk + 16 * i) * 3072 + hh * 128;                         \
      rq[i] = *(const u32x4*)(qb_ + lo_k);                                                               \
      rk[i] = *(const u32x4*)((qb_ + 1024) + lo_k);                                                      \
    }                                                                                                    \
    _Pragma("unroll") for (int i = 0; i < NA; ++i) {                                                     \
      const int idx = tid + 256 * i;                                                                     \
      if (idx < C * C / 8) ra[i] = *(const u32x4*)(asrc + (idx / (C / 8)) * C + (idx % (C / 8)) * 8);    \
    }                                                                                                    \
  }
#define SCAN_STORE2()                                                                                    \
  {                                                                                                      \
    const int tid = otid();                                                            \
    _Pragma("unroll") for (int i = 0; i < NI; ++i) {                                                     \
      const int idx = tid + 256 * i, row = idx >> 4, ch = idx & 15;                                      \
      *(u32x4*)(qds + row * 136 + ch * 8) = rq[i];                                                       \
      const int f8 = idx * 8;                                                                            \
      *(u32x4*)(kts + (f8 / C) * 72 + (f8 % C)) = rk[i];                                                 \
    }                                                                                                    \
    _Pragma("unroll") for (int i = 0; i < NA; ++i) {                                                     \
      const int idx = tid + 256 * i;                                                                     \
      if (idx < C * C / 8) *(u32x4*)(asm_ + (idx / (C / 8)) * 72 + (idx % (C / 8)) * 8) = ra[i];         \
    }                                                                                                    \
  }
  __syncthreads();
  SCAN_LOAD1(0); SCAN_LOAD2(0);
  SCAN_STORE1(); SCAN_STORE2();
  __syncthreads();
  for (int n = 0; n < nchunks; ++n) {
    const bool have_next = n + 1 < nchunks;
    const unsigned tok0 = tok_of(n);
    const int tid = otid(), w = tid >> 6, lane = tid & 63, r = lane & 31, h = lane >> 5;
    if (have_next && ((n + 1) & 15) == 0) wait_group((n + 1) >> 4);
    if (have_next) SCAN_LOAD1(n + 1);
    const float gl = __uint_as_float(__hip_atomic_load((const unsigned*)GL + task_of(n), __ATOMIC_RELAXED, __HIP_MEMORY_SCOPE_AGENT));
    f32x16 e[RT];
#pragma unroll
    for (int rt = 0; rt < RT; ++rt)
#pragma unroll
      for (int i = 0; i < 16; ++i) e[rt][i] = -bf2f(us[(rt * 32 + crow(i, h)) * 136 + w * 32 + r]);
#pragma unroll
    for (int d = 0; d < 4; ++d)
#pragma unroll
      for (int t = 0; t < 2; ++t) {
        asm volatile("" ::: "memory");
        const bf16x8 sb = pack8(S[d], t);
#pragma unroll
        for (int rt = 0; rt < RT; ++rt) {
          bf16x8 aw = ld_a2(wsm + (rt * 32 + r) * 136 + d * 32 + 16 * t + 4 * h);
          e[rt] = MFMA(aw, sb, e[rt]);
        }
      }
    __syncthreads();
    if (have_next) { SCAN_STORE1(); SCAN_LOAD2(n + 1); }
    bf16x8 ebf[RT][2];
#pragma unroll
    for (int rt = 0; rt < RT; ++rt) {
#pragma unroll
      for (int i = 0; i < 16; ++i) e[rt][i] = -e[rt][i];
      ebf[rt][0] = pack8(e[rt], 0); ebf[rt][1] = pack8(e[rt], 1);
    }
#pragma unroll 1
    for (int rt = 0; rt < RT; ++rt) {
      const int tid = otid(), w = tid >> 6, lane = tid & 63, r = lane & 31, h = lane >> 5;
      f32x16 o = zero16();
#pragma unroll
      for (int d = 0; d < 4; ++d)
#pragma unroll
        for (int t = 0; t < 2; ++t) {
          if (t == 0) asm volatile("" ::: "memory");
          bf16x8 aq = ld_a2(qds + (rt * 32 + r) * 136 + d * 32 + 16 * t + 4 * h);
          o = MFMA(aq, pack8(S[d], t), o);
        }
#pragma unroll
      for (int jt = 0; jt < RT; ++jt)
#pragma unroll
        for (int t = 0; t < 2; ++t) {
          if (t == 0) asm volatile("" ::: "memory");
          bf16x8 aa = ld_a2(asm_ + (rt * 32 + r) * 72 + jt * 32 + 16 * t + 4 * h);
          o = MFMA(aa, ebf[jt][t], o);
        }
#pragma unroll
      for (int i = 0; i < 16; ++i) {
        u16* orow = QKV + (size_t)(tok0 + rt * 32 + (i & 3) + 8 * (i >> 2)) * 3072 + 2048 + hh * 128;
        orow[(unsigned)(4 * h * 3072 + w * 32 + r)] = f2bf(o[i]);
      }
    }
    const int tid3 = otid(), lane3 = tid3 & 63, r3 = lane3 & 31, h3 = lane3 >> 5;
#pragma unroll
    for (int d = 0; d < 4; ++d)
#pragma unroll
      for (int i = 0; i < 16; ++i) S[d][i] *= gl;
#pragma unroll
    for (int jt = 0; jt < RT; ++jt)
#pragma unroll
      for (int t = 0; t < 2; ++t) {
        asm volatile("" ::: "memory");
        const bf16x8 eb = ebf[jt][t];
#pragma unroll
        for (int d = 0; d < 4; ++d) {
          bf16x8 ak = ld_a2(kts + (d * 32 + r3) * 72 + jt * 32 + 16 * t + 4 * h3);
          S[d] = MFMA(ak, eb, S[d]);
        }
      }
    __syncthreads();
    if (have_next) SCAN_STORE2();
    __syncthreads();
  }
#undef SCAN_LOAD1
#undef SCAN_STORE1
#undef SCAN_LOAD2
#undef SCAN_STORE2
  asm volatile("s_waitcnt vmcnt(0)" ::: "memory");
  __syncthreads();
  __builtin_amdgcn_fence(__ATOMIC_ACQUIRE, "agent");
  {
    const int tidf = otid(), l8 = tidf & 7;
    const int nrows = SAMPLE ? 32 : 8192; const unsigned tokb = SAMPLE ? (unsigned)NP + b * 32 : (unsigned)b * 8192;
    const u16* ZA = (const u16*)(p.ws + OFF_ZA);
    const float* gp = p.g_gdn + l8 * 16;
    for (int row = tidf >> 3; row < nrows; row += 32) {
      u16* op = QKV + (tokb + row) * 3072 + 2048 + hh * 128 + l8 * 16;
      const u16* zp = ZA + (tokb + row) * 1024 + hh * 128 + l8 * 16;
      const uint4 o0 = *(const uint4*)op, o1 = *(const uint4*)(op + 8);
      const uint4 z0 = *(const uint4*)zp, z1 = *(const uint4*)(zp + 8);
      float v[16] = {bflo(o0.x), bfhi(o0.x), bflo(o0.y), bfhi(o0.y), bflo(o0.z), bfhi(o0.z), bflo(o0.w), bfhi(o0.w),
                     bflo(o1.x), bfhi(o1.x), bflo(o1.y), bfhi(o1.y), bflo(o1.z), bfhi(o1.z), bflo(o1.w), bfhi(o1.w)};
      float zz[16] = {bflo(z0.x), bfhi(z0.x), bflo(z0.y), bfhi(z0.y), bflo(z0.z), bfhi(z0.z), bflo(z0.w), bfhi(z0.w),
                      bflo(z1.x), bfhi(z1.x), bflo(z1.y), bfhi(z1.y), bflo(z1.z), bfhi(z1.z), bflo(z1.w), bfhi(z1.w)};
      float ss = 0.f;
#pragma unroll
      for (int j = 0; j < 16; ++j) ss += v[j] * v[j];
      ss += __shfl_xor(ss, 1); ss += __shfl_xor(ss, 2); ss += __shfl_xor(ss, 4);
      const float rstd = rsqrtf(ss * (1.f / 128.f) + EPSF);
      unsigned ow[8];
#pragma unroll
      for (int j = 0; j < 8; ++j) ow[j] = pk2(v[2 * j] * rstd * gp[2 * j] * silu(zz[2 * j]), v[2 * j + 1] * rstd * gp[2 * j + 1] * silu(zz[2 * j + 1]));
      *(uint4*)op = make_uint4(ow[0], ow[1], ow[2], ow[3]);
      *(uint4*)(op + 8) = make_uint4(ow[4], ow[5], ow[6], ow[7]);
    }
  }
  float* so = p.out + (SAMPLE ? O_SS : O_SP) + (size_t)(b * 8 + hh) * 128 * 128;
#pragma unroll
  for (int d = 0; d < 4; ++d)
#pragma unroll
    for (int i = 0; i < 16; ++i) { float* srow = so + (d * 32 + (i & 3) + 8 * (i >> 2)) * 128; srow[(unsigned)(4 * h * 128 + w * 32 + r)] = S[d][i]; }
}

DI void phase2(const Params& p) {
  __shared__ int s_task;
  unsigned* ctr = (unsigned*)(p.ws + OFF_CTR);
  constexpr int NPRE = 192 + 128 + 8192 + 64, NPOST = 2048 + 64;
  int stage = 0, steal = 0; const unsigned xcc = xcc_id();
  while (true) {
    __syncthreads();
    if (otid() == 0) {
      int code = -1;
      if (stage == 0) { const int t = (int)atomicAdd(ctr, 1u); if (t < NPRE) code = t; else stage = 1; }
      if (stage == 1) { const int q = (int)atomicAdd(ctr + 8, 1u); if (q < 2048) code = NPRE + q; else stage = 2; }
      if (stage == 2) { const int t = (int)atomicAdd(ctr + 1, 1u); if (t < NPOST) code = NPRE + 4096 + t; }
      s_task = code;
    }
    __syncthreads();
    int t = __builtin_amdgcn_readfirstlane(s_task);
    if (t < 0) break;
#ifndef TM
#define TM 127
#endif
    if (t < 64) { if (TM & 64) scan_task<2>(p, t >> 3, t & 7); continue; }
    if (t < 192) { if (TM & 64) scan_task<1>(p, (t - 64) >> 3, (t - 64) & 7); continue; }
    t -= 192;
    if (t < 128) { if (TM & 8) g1_task<32>(p, 8192 + t); continue; }
    t -= 128;
    if (t < 8192) { if (TM & 4) { const int n = t >> 6, s = t & 63; g1_task<64>(p, ((s >> 3) * 128 + n) * 8 + (s & 7)); } continue; }
    t -= 8192;
    if (t < 64) { if (TM & 2) attn_sample<true>(p, t >> 2, t & 3); continue; }
    t -= 64;
    if (t < 4096) {
      if (TM & 1) { if (t < 2048) attn_b_prompt2(p, t & 31, 63 - (t >> 5)); }
      continue;
    }
    t -= 4096;
    if (t < 2048) { if (TM & 16) attn_c_prompt(p, t >> 2, t & 3); continue; }
    t -= 2048;
    if (TM & 32) attn_sample<false>(p, t >> 2, t & 3);
  }
}

DI void phase3b(const Params& p) {
  const int tid = otid(), w = tid >> 6, lane = tid & 63;
  u16* QKV = (u16*)(p.ws + OFF_QKV); const u16* ZA = (const u16*)(p.ws + OFF_ZA);
  for (int row = blockIdx.x * 4 + w; row < NT; row += gridDim.x * 4) {
    u16* op = QKV + (unsigned)row * 3072u + 2048 + lane * 16;
    const u16* zp = ZA + (unsigned)row * 1024u + lane * 16;
    const uint4 o0 = *(const uint4*)op, o1 = *(const uint4*)(op + 8);
    const uint4 z0 = *(const uint4*)zp, z1 = *(const uint4*)(zp + 8);
    float v[16] = {bflo(o0.x), bfhi(o0.x), bflo(o0.y), bfhi(o0.y), bflo(o0.z), bfhi(o0.z), bflo(o0.w), bfhi(o0.w),
                   bflo(o1.x), bfhi(o1.x), bflo(o1.y), bfhi(o1.y), bflo(o1.z), bfhi(o1.z), bflo(o1.w), bfhi(o1.w)};
    float zz[16] = {bflo(z0.x), bfhi(z0.x), bflo(z0.y), bfhi(z0.y), bflo(z0.z), bfhi(z0.z), bflo(z0.w), bfhi(z0.w),
                    bflo(z1.x), bfhi(z1.x), bflo(z1.y), bfhi(z1.y), bflo(z1.z), bfhi(z1.z), bflo(z1.w), bfhi(z1.w)};
    float ss = 0.f;
#pragma unroll
    for (int j = 0; j < 16; ++j) ss += v[j] * v[j];
    ss += __shfl_xor(ss, 1); ss += __shfl_xor(ss, 2); ss += __shfl_xor(ss, 4);
    const float rstd = rsqrtf(ss * (1.f / 128.f) + EPSF);
    const float* gp = p.g_gdn + (lane & 7) * 16;
    unsigned ow[8];
#pragma unroll
    for (int j = 0; j < 8; ++j) ow[j] = pk2(v[2 * j] * rstd * gp[2 * j] * silu(zz[2 * j]), v[2 * j + 1] * rstd * gp[2 * j + 1] * silu(zz[2 * j + 1]));
    *(uint4*)op = make_uint4(ow[0], ow[1], ow[2], ow[3]);
    *(uint4*)(op + 8) = make_uint4(ow[4], ow[5], ow[6], ow[7]);
  }
}

DI void phase4(const Params& p) {
  const int tid = otid(), w = tid >> 6, lane = tid & 63, r = lane & 31, h = lane >> 5, wm = w >> 1, wn = w & 1;
  const u16* QKV = (const u16*)(p.ws + OFF_QKV); const u16* MIXB = (const u16*)(p.ws + OFF_QB); const u16* MIXC = (const u16*)(p.ws + OFF_QC);
  const u16* WoutT = (const u16*)(p.ws + OFF_WOUTT);
  __shared__ int s_t4;
  int steal4 = 0; const unsigned xcc4 = xcc_id();
  while (true) {
    __syncthreads();
    if (otid() == 0) s_t4 = xq_fetch((unsigned*)(p.ws + OFF_CTR) + 24, 258, xcc4, steal4);
    __syncthreads();
    const int tq = __builtin_amdgcn_readfirstlane(s_t4);
    if (tq < 0) break;
    const int xq = tq / 258, jq = tq % 258;
    const int nt = xq & 3, mt = jq * 2 + (xq >> 2), m0 = mt * 128, n0 = nt * 256;
    f32x16 acc[2][4];
#pragma unroll
    for (int a = 0; a < 2; ++a)
#pragma unroll
      for (int b = 0; b < 4; ++b) acc[a][b] = zero16();
    gemm_core<true>(QKV + (size_t)m0 * 3072 + 2048, 3072, MIXB + (size_t)m0 * 512, 512, MIXC + (size_t)m0 * 512, 512, 16, 24, WoutT + (size_t)n0 * 2048, 2048, 32, acc);
#pragma unroll
    for (int rt = 0; rt < 2; ++rt) {
      const int row = m0 + wm * 64 + rt * 32 + r;
      const float* xr = row < NP ? p.x_prompt + (unsigned)(row * 1024) : p.x_sample + (unsigned)((row - NP) * 1024);
      float* yr = p.out + (unsigned)(row * 1024);
#pragma unroll
      for (int ct = 0; ct < 4; ++ct)
#pragma unroll
        for (int q = 0; q < 4; ++q) {
          const int col = n0 + wn * 128 + ct * 32 + 8 * q + 4 * h;
          const float4 xv = *(const float4*)(xr + col);
          st16_wt(yr + col, make_uint4(__float_as_uint(xv.x + acc[rt][ct][4 * q]), __float_as_uint(xv.y + acc[rt][ct][4 * q + 1]), __float_as_uint(xv.z + acc[rt][ct][4 * q + 2]), __float_as_uint(xv.w + acc[rt][ct][4 * q + 3])));
        }
    }
    asm volatile("s_waitcnt vmcnt(0)" ::: "memory");
    __syncthreads();
    if (otid() == 0) {
      const unsigned old = __hip_atomic_fetch_add((unsigned*)(p.ws + OFF_CTR) + 1024 + mt, 1u, __ATOMIC_RELAXED, __HIP_MEMORY_SCOPE_AGENT);
      s_t4 = (old == 3u) ? 1 : 0;
    }
    __syncthreads();
    if (__builtin_amdgcn_readfirstlane(s_t4)) {
      __builtin_amdgcn_fence(__ATOMIC_ACQUIRE, "agent");
      asm volatile("s_waitcnt vmcnt(0)" ::: "memory");
      const int tid2 = otid(), w2 = tid2 >> 6, lane2 = tid2 & 63;
#pragma unroll 2
      for (int rr = 0; rr < 32; ++rr) {
        float* y = p.out + (unsigned)((m0 + w2 * 32 + rr) * 1024);
        float4 xv[4]; float ss = 0.f;
#pragma unroll
        for (int i = 0; i < 4; ++i) { xv[i] = *(const float4*)(y + i * 256 + lane2 * 4); ss += xv[i].x * xv[i].x + xv[i].y * xv[i].y + xv[i].z * xv[i].z + xv[i].w * xv[i].w; }
        ss = wave_sum(ss);
        const float rstd = rsqrtf(ss * (1.f / 1024.f) + EPSF);
#pragma unroll
        for (int i = 0; i < 4; ++i) {
          const float4 gv = *(const float4*)(p.g_final + i * 256 + lane2 * 4);
          xv[i].x *= rstd * gv.x; xv[i].y *= rstd * gv.y; xv[i].z *= rstd * gv.z; xv[i].w *= rstd * gv.w;
          *(float4*)(y + i * 256 + lane2 * 4) = xv[i];
        }
      }
    }
  }
}

DI void phase5(const Params& p) {
  const int tid = otid(), w = tid >> 6, lane = tid & 63;
  for (int row = blockIdx.x * 4 + w; row < NT; row += gridDim.x * 4) {
    float* y = p.out + (size_t)row * 1024;
    float4 xv[4]; float ss = 0.f;
#pragma unroll
    for (int i = 0; i < 4; ++i) { xv[i] = *(const float4*)(y + i * 256 + lane * 4); ss += xv[i].x * xv[i].x + xv[i].y * xv[i].y + xv[i].z * xv[i].z + xv[i].w * xv[i].w; }
    ss = wave_sum(ss);
    const float rstd = rsqrtf(ss * (1.f / 1024.f) + EPSF);
#pragma unroll
    for (int i = 0; i < 4; ++i) {
      float4 gv = *(const float4*)(p.g_final + i * 256 + lane * 4);
      xv[i].x *= rstd * gv.x; xv[i].y *= rstd * gv.y; xv[i].z *= rstd * gv.z; xv[i].w *= rstd * gv.w;
      *(float4*)(y + i * 256 + lane * 4) = xv[i];
    }
  }
}

__global__ void __launch_bounds__(256, 2) mega(Params p, int ph_lo, int ph_hi) {
  cg::grid_group grid = cg::this_grid();
#ifndef PM
#define PM 63
#endif
  if (ph_lo <= 0 && ph_hi >= 0) { if (PM & 1) phase0(p); }
  if (ph_lo <= 0 && ph_hi >= 1) grid.sync();
  if (ph_lo <= 1 && ph_hi >= 1) { if (PM & 2) phase1(p); }
  if (ph_lo <= 1 && ph_hi >= 2) grid.sync();
  if (ph_lo <= 2 && ph_hi >= 2) { if (PM & 4) phase2(p); }
  if (ph_lo <= 2 && ph_hi >= 4) grid.sync();
  if (ph_lo <= 4 && ph_hi >= 4) { if (PM & 16) phase4(p); }
}

extern "C" void kernel_launch(void* const* d_in, const int* in_sizes, int n_in, void* d_out, int out_size, void* d_ws, size_t ws_size, hipStream_t stream) {
  static int grid_blocks = 0;
  if (!grid_blocks) {
    int dev = 0, cus = 0, per_cu = 0;
    hipGetDevice(&dev);
    hipDeviceGetAttribute(&cus, hipDeviceAttributeMultiprocessorCount, dev);
    hipOccupancyMaxActiveBlocksPerMultiprocessor(&per_cu, mega, 256, 0);
    if (per_cu < 1) per_cu = 1;
    if (per_cu > 2) per_cu = 2;
    grid_blocks = cus * per_cu;
  }
  Params p{};
  p.x_prompt = (const float*)d_in[0]; p.x_sample = (const float*)d_in[1]; p.mem_prompt = (const float*)d_in[2];
  p.cache_diff_k = (const float*)d_in[3]; p.cache_diff_v = (const float*)d_in[4]; p.cache_mem_k = (const float*)d_in[5]; p.cache_mem_v = (const float*)d_in[6];
  p.state_gdn = (const float*)d_in[7]; p.cache_conv = (const float*)d_in[8]; p.g_pre = (const float*)d_in[9]; p.w_in = (const float*)d_in[10];
  p.conv_w = (const float*)d_in[11]; p.a_log = (const float*)d_in[12]; p.dt_bias = (const float*)d_in[13]; p.g_gdn = (const float*)d_in[14];
  p.lam_vec = (const float*)d_in[15]; p.g_sub = (const float*)d_in[16]; p.g_mem = (const float*)d_in[17]; p.w_mem_kv = (const float*)d_in[18];
  p.w_out = (const float*)d_in[19]; p.g_final = (const float*)d_in[20];
  p.out = (float*)d_out; p.ws = (char*)d_ws;
  hipMemsetAsync((char*)d_ws + OFF_CTR, 0, 8192, stream);
#if ONE_LAUNCH
  int lo = 0, hi = 5;
  void* args[] = {&p, &lo, &hi};
  hipError_t e = hipLaunchCooperativeKernel((void*)mega, dim3(grid_blocks), dim3(256), args, 0, stream);
  if (e != hipSuccess) fprintf(stderr, "cooperative launch failed: %s (grid %d)\n", hipGetErrorString(e), grid_blocks);
#else
  for (int ph = 0; ph <= 5; ++ph) hipLaunchKernelGGL(mega, dim3(grid_blocks), dim3(256), 0, stream, p, ph, ph);
#endif
}
```

```cpp
#include <hip/hip_runtime.h>
#include <hip/hip_cooperative_groups.h>
#include <cstdio>
#include <cstdint>
namespace cg = cooperative_groups;

#ifndef ONE_LAUNCH
#define ONE_LAUNCH 1
#endif

typedef __attribute__((ext_vector_type(8))) short bf16x8;
typedef __attribute__((ext_vector_type(4))) short s16x4;
typedef __attribute__((ext_vector_type(16))) float f32x16;
typedef __attribute__((ext_vector_type(2))) __bf16 bf2_t;
typedef unsigned short u16;
typedef __attribute__((ext_vector_type(4))) unsigned u32x4;
typedef __attribute__((ext_vector_type(2))) unsigned u32x2;
#define DI __device__ __forceinline__
#define MFMA(a, b, c) __builtin_amdgcn_mfma_f32_32x32x16_bf16((a), (b), (c), 0, 0, 0)

constexpr int NP = 65536;
constexpr int NS = 512;
constexpr int NT = NP + NS;
constexpr float EPSF = 1e-6f;

constexpr size_t SZ_QKV = (size_t)NT * 3072 * 2;
constexpr size_t SZ_1024 = (size_t)NT * 1024 * 2;
constexpr size_t SZ_512 = (size_t)NT * 512 * 2;
constexpr size_t OFF_QKV = 0;
constexpr size_t OFF_ZA = OFF_QKV + SZ_QKV;
constexpr size_t OFF_QB = OFF_ZA + SZ_1024;
constexpr size_t OFF_KB = OFF_QB + SZ_512;
constexpr size_t OFF_ZB = OFF_KB + SZ_512;
constexpr size_t OFF_QC = OFF_ZB + SZ_512;
constexpr size_t OFF_ZC = OFF_QC + SZ_512;
constexpr size_t OFF_VBT = OFF_ZC + SZ_512;
constexpr size_t VBT_S_EL = (size_t)8 * 4 * 128 * 8192;
constexpr size_t OFF_WINT = OFF_VBT + SZ_512;
constexpr size_t OFF_WOUTT = OFF_WINT + (size_t)7168 * 1024 * 2;
constexpr size_t OFF_WMEMT = OFF_WOUTT + (size_t)1024 * 2048 * 2;
constexpr size_t OFF_MEMN = OFF_WMEMT + (size_t)1024 * 1024 * 2;
constexpr size_t OFF_MEMK = OFF_MEMN + (size_t)2048 * 1024 * 2;
constexpr size_t OFF_MEMVT = OFF_MEMK + (size_t)2048 * 512 * 2;
constexpr size_t OFF_BA = OFF_MEMVT + (size_t)2048 * 512 * 2;
constexpr size_t OFF_GL = OFF_BA + (size_t)NT * 16 * 4;
constexpr size_t OFF_CTR = OFF_GL + (size_t)8320 * 4;
constexpr size_t WS_NEED = OFF_CTR + 8192;
constexpr size_t YO_H = 0;
constexpr size_t YO_W = 0;
constexpr size_t YO_HALO = (size_t)8320 * 8192 * 2;
constexpr size_t YO_ATT = YO_HALO + (size_t)8 * 128 * 3 * 3072 * 2;
constexpr size_t O_YP = 0;
constexpr size_t O_YS = O_YP + (size_t)NP * 1024;
constexpr size_t O_KP = O_YS + (size_t)NS * 1024;
constexpr size_t O_VP = O_KP + (size_t)NP * 512;
constexpr size_t O_MK = O_VP + (size_t)NP * 512;
constexpr size_t O_MV = O_MK + (size_t)2048 * 512;
constexpr size_t O_SP = O_MV + (size_t)2048 * 512;
constexpr size_t O_CP = O_SP + (size_t)8 * 8 * 128 * 128;
constexpr size_t O_KS = O_CP + (size_t)8 * 3 * 3072;
constexpr size_t O_VS = O_KS + (size_t)NS * 512;
constexpr size_t O_SS = O_VS + (size_t)NS * 512;
constexpr size_t O_CS = O_SS + (size_t)16 * 8 * 128 * 128;

struct Params {
  const float *x_prompt, *x_sample, *mem_prompt, *cache_diff_k, *cache_diff_v, *cache_mem_k, *cache_mem_v, *state_gdn, *cache_conv;
  const float *g_pre, *w_in, *conv_w, *a_log, *dt_bias, *g_gdn, *lam_vec, *g_sub, *g_mem, *w_mem_kv, *w_out, *g_final;
  float* out;
  char* ws;
};

__shared__ __attribute__((aligned(16))) char smem[79872];

DI unsigned pk2(float a, float b) { bf2_t v; v[0] = (__bf16)a; v[1] = (__bf16)b; return __builtin_bit_cast(unsigned, v); }
DI u16 f2bf(float a) { return __builtin_bit_cast(u16, (__bf16)a); }
DI float bf2f(u16 v) { return __uint_as_float(((unsigned)v) << 16); }
DI float bflo(unsigned v) { return __uint_as_float(v << 16); }
DI float bfhi(unsigned v) { return __uint_as_float(v & 0xffff0000u); }
DI int otid() { int t = threadIdx.x; asm volatile("" : "+v"(t)); return t; }
DI void st16_wt(void* ptr, uint4 v) { u32x4 d = {v.x, v.y, v.z, v.w}; asm volatile("global_store_dwordx4 %0, %1, off sc1\n\ts_nop 1" :: "v"(ptr), "v"(d) : "memory"); }
DI void st2_wt(void* ptr, u16 v) { unsigned d = v; asm volatile("global_store_short %0, %1, off sc1\n\ts_nop 1" :: "v"(ptr), "v"(d) : "memory"); }
DI int swap23(int k) { return (k & ~12) | ((k & 4) << 1) | ((k & 8) >> 1); }
DI int crow(int reg, int h) { return (reg & 3) + 8 * (reg >> 2) + 4 * h; }
DI float wave_sum(float v) { for (int o = 32; o > 0; o >>= 1) v += __shfl_xor(v, o); return v; }
DI float silu(float z) { return z * __builtin_amdgcn_rcpf(1.f + __expf(-z)); }
DI bf16x8 pack8(const f32x16& x, int t) {
  uint4 p; p.x = pk2(x[8 * t], x[8 * t + 1]); p.y = pk2(x[8 * t + 2], x[8 * t + 3]); p.z = pk2(x[8 * t + 4], x[8 * t + 5]); p.w = pk2(x[8 * t + 6], x[8 * t + 7]);
  return __builtin_bit_cast(bf16x8, p);
}
DI void st_perm16(u16* rowbase, int ch, u32x4 v) {
  u16* q = rowbase + 16 * (ch >> 1) + 4 * (ch & 1);
  *(u32x2*)q = v.xy; *(u32x2*)(q + 8) = v.zw;
}
DI bf16x8 ld_a2(const u16* p) {
  s16x4 lo = *(const s16x4*)p; s16x4 hi = *(const s16x4*)(p + 8);
  return __builtin_shufflevector(lo, hi, 0, 1, 2, 3, 4, 5, 6, 7);
}
DI f32x16 zero16() { f32x16 z; _Pragma("unroll") for (int i = 0; i < 16; ++i) z[i] = 0.f; return z; }

DI void p0_transpose_tile(const float* src, int ld_src, int k0, int srccol0, u16* dst, int ld_dst, int n0) {
  float* t = (float*)smem;
  const int tid = otid(), r = tid >> 6, c = tid & 63;
  for (int i = 0; i < 16; ++i) { int row = r + 4 * i; t[row * 65 + c] = src[(size_t)(k0 + row) * ld_src + srccol0 + c]; }
  __syncthreads();
  for (int i = 0; i < 16; ++i) { int n = r + 4 * i; dst[(size_t)(n0 + n) * ld_dst + k0 + c] = f2bf(t[c * 65 + n]); }
  __syncthreads();
}

DI void phase0(const Params& p) {
  const int tid = otid();
  u16* WinT = (u16*)(p.ws + OFF_WINT); u16* WoutT = (u16*)(p.ws + OFF_WOUTT); u16* WmemT = (u16*)(p.ws + OFF_WMEMT);
  for (int t = blockIdx.x; t < 2560; t += gridDim.x) {
    if (t < 1792) { int kt = t / 112, nt = t % 112; int n0 = nt * 64; int sc = n0 < 4096 ? n0 : n0 + 16; p0_transpose_tile(p.w_in, 7184, kt * 64, sc, WinT, 1024, n0); }
    else if (t < 2304) { int u = t - 1792; int kt = u / 16, nt = u % 16; p0_transpose_tile(p.w_out, 1024, kt * 64, nt * 64, WoutT, 2048, nt * 64); }
    else { int u = t - 2304; int kt = u / 16, nt = u % 16; p0_transpose_tile(p.w_mem_kv, 1024, kt * 64, nt * 64, WmemT, 1024, nt * 64); }
  }
  float* wab = (float*)smem;
  __syncthreads();
  for (int i = 0; i < 64; ++i) { int idx = tid + 256 * i; int k = idx >> 4, j = idx & 15; wab[j * 1024 + k] = p.w_in[(size_t)k * 7184 + 4096 + j]; }
  __syncthreads();
  const int w = tid >> 6, lane = tid & 63;
  u16* H = (u16*)((char*)p.out + YO_H); u16* MEMN = (u16*)(p.ws + OFF_MEMN); float* BA = (float*)(p.ws + OFF_BA);
  for (int row = blockIdx.x * 4 + w; row < NT + 2048; row += gridDim.x * 4) {
    const float* src; const float* g; u16* dst;
    if (row < NP) { src = p.x_prompt + (size_t)row * 1024; g = p.g_pre; dst = H + (size_t)row * 1024; }
    else if (row < NT) { src = p.x_sample + (size_t)(row - NP) * 1024; g = p.g_pre; dst = H + (size_t)row * 1024; }
    else { src = p.mem_prompt + (size_t)(row - NT) * 1024; g = p.g_mem; dst = MEMN + (size_t)(row - NT) * 1024; }
    float4 xv[4]; float ss = 0.f;
#pragma unroll
    for (int i = 0; i < 4; ++i) { xv[i] = *(const float4*)(src + i * 256 + lane * 4); ss += xv[i].x * xv[i].x + xv[i].y * xv[i].y + xv[i].z * xv[i].z + xv[i].w * xv[i].w; }
    ss = wave_sum(ss);
    const float rstd = rsqrtf(ss * (1.f / 1024.f) + EPSF);
#pragma unroll
    for (int i = 0; i < 4; ++i) {
      float4 gv = *(const float4*)(g + i * 256 + lane * 4);
      xv[i].x *= rstd * gv.x; xv[i].y *= rstd * gv.y; xv[i].z *= rstd * gv.z; xv[i].w *= rstd * gv.w;
      uint2 o; o.x = pk2(xv[i].x, xv[i].y); o.y = pk2(xv[i].z, xv[i].w);
      *(uint2*)(dst + i * 256 + lane * 4) = o;
    }
    if (row < NT) {
      float v[16];
#pragma unroll
      for (int j = 0; j < 16; ++j) {
        float a = 0.f;
#pragma unroll
        for (int i = 0; i < 4; ++i) { float4 wv = *(const float4*)(wab + j * 1024 + i * 256 + lane * 4); a += xv[i].x * wv.x + xv[i].y * wv.y + xv[i].z * wv.z + xv[i].w * wv.w; }
        v[j] = a;
        if ((j & 3) == 3) asm volatile("" ::: "memory");
      }
      { const bool up = lane & 32;
        _Pragma("unroll") for (int t = 0; t < 8; ++t) { const float send = up ? v[t] : v[t + 8]; const float keep = up ? v[t + 8] : v[t]; v[t] = keep + __shfl_xor(send, 32); } }
      { const bool up = lane & 16;
        _Pragma("unroll") for (int t = 0; t < 4; ++t) { const float send = up ? v[t] : v[t + 4]; const float keep = up ? v[t + 4] : v[t]; v[t] = keep + __shfl_xor(send, 16); } }
      { const bool up = lane & 8;
        _Pragma("unroll") for (int t = 0; t < 2; ++t) { const float send = up ? v[t] : v[t + 2]; const float keep = up ? v[t + 2] : v[t]; v[t] = keep + __shfl_xor(send, 8); } }
      { const bool up = lane & 4; const float send = up ? v[0] : v[1]; const float keep = up ? v[1] : v[0]; v[0] = keep + __shfl_xor(send, 4); }
      v[0] += __shfl_xor(v[0], 2); v[0] += __shfl_xor(v[0], 1);
      if ((lane & 3) == 0) { const int j = ((lane >> 5) & 1) * 8 + ((lane >> 4) & 1) * 4 + ((lane >> 3) & 1) * 2 + ((lane >> 2) & 1); BA[(size_t)row * 16 + j] = v[0]; }
    }
  }
}

DI unsigned xcc_id() { return (unsigned)__builtin_amdgcn_s_getreg((3 << 11) | 20) & 7u; }
DI int xq_fetch(unsigned* q8, int per, unsigned xcc, int& steal) {
  while (steal < 8) {
    const unsigned x = (xcc + steal) & 7u;
    const int q = (int)atomicAdd(q8 + x, 1u);
    if (q < per) return (int)x * per + q;
    ++steal;
  }
  return -1;
}

struct GRegs { u32x4 a0, a1, a2, a3, b0, b1, b2, b3, b4, b5, b6, b7; };
DI void gemm_gload(GRegs& g, int kt, const u16* ap0, int ld0, const u16* ap1, int ld1, const u16* ap2, int ld2, int kt1, int kt2, const u16* Bt, int ldb) {
  const int tid = otid();
  const u16* ap; int lda; int kk;
  if (kt < kt1) { ap = ap0; lda = ld0; kk = kt; } else if (kt < kt2) { ap = ap1; lda = ld1; kk = kt - kt1; } else { ap = ap2; lda = ld2; kk = kt - kt2; }
  const int row = tid >> 3, ch = tid & 7;
  const u16* pa = ap + (unsigned)(row * lda + kk * 64 + ch * 8);
  const u16* pb = Bt + (unsigned)(row * ldb + kt * 64 + ch * 8);
  g.a0 = *(const u32x4*)(pa); g.a1 = *(const u32x4*)(pa + (unsigned)(32 * lda)); g.a2 = *(const u32x4*)(pa + (unsigned)(64 * lda)); g.a3 = *(const u32x4*)(pa + (unsigned)(96 * lda));
  g.b0 = *(const u32x4*)(pb); g.b1 = *(const u32x4*)(pb + (unsigned)(32 * ldb)); g.b2 = *(const u32x4*)(pb + (unsigned)(64 * ldb)); g.b3 = *(const u32x4*)(pb + (unsigned)(96 * ldb));
  g.b4 = *(const u32x4*)(pb + (unsigned)(128 * ldb)); g.b5 = *(const u32x4*)(pb + (unsigned)(160 * ldb)); g.b6 = *(const u32x4*)(pb + (unsigned)(192 * ldb)); g.b7 = *(const u32x4*)(pb + (unsigned)(224 * ldb));
}
DI void gemm_store(const GRegs& g, u16* As) {
  const int tid = otid(); const int srow = tid >> 3, sch = tid & 7;
  u16* pa = As + srow * 72 + sch * 8; u16* pb = pa + 128 * 72;
  *(u32x4*)(pa) = g.a0; *(u32x4*)(pa + 32 * 72) = g.a1; *(u32x4*)(pa + 64 * 72) = g.a2; *(u32x4*)(pa + 96 * 72) = g.a3;
  *(u32x4*)(pb) = g.b0; *(u32x4*)(pb + 32 * 72) = g.b1; *(u32x4*)(pb + 64 * 72) = g.b2; *(u32x4*)(pb + 96 * 72) = g.b3;
  *(u32x4*)(pb + 128 * 72) = g.b4; *(u32x4*)(pb + 160 * 72) = g.b5; *(u32x4*)(pb + 192 * 72) = g.b6; *(u32x4*)(pb + 224 * 72) = g.b7;
}
template <bool SWAP>
DI void gemm_core(const u16* ap0, int ld0, const u16* ap1, int ld1, const u16* ap2, int ld2, int kt1, int kt2, const u16* Bt, int ldb, int nk, f32x16 (&acc)[2][4]) {
  const int tid = otid(), w = tid >> 6, lane = tid & 63, r = lane & 31, h = lane >> 5, wm = w >> 1, wn = w & 1;
  const u16* As = (const u16*)smem; const u16* Bs = As + 128 * 72;
  GRegs g;
  gemm_gload(g, 0, ap0, ld0, ap1, ld1, ap2, ld2, kt1, kt2, Bt, ldb);
  __syncthreads();
  gemm_store(g, (u16*)smem);
  __syncthreads();
  for (int kt = 0; kt < nk; ++kt) {
    if (kt + 1 < nk) gemm_gload(g, kt + 1, ap0, ld0, ap1, ld1, ap2, ld2, kt1, kt2, Bt, ldb);
#pragma unroll
    for (int ks = 0; ks < 4; ++ks) {
      bf16x8 a0 = *(const bf16x8*)(As + (wm * 64 + r) * 72 + ks * 16 + h * 8);
      bf16x8 a1 = *(const bf16x8*)(As + (wm * 64 + 32 + r) * 72 + ks * 16 + h * 8);
#pragma unroll
      for (int ct = 0; ct < 4; ++ct) {
        bf16x8 b = *(const bf16x8*)(Bs + (wn * 128 + ct * 32 + r) * 72 + ks * 16 + h * 8);
        if (SWAP) { acc[0][ct] = MFMA(b, a0, acc[0][ct]); acc[1][ct] = MFMA(b, a1, acc[1][ct]); }
        else { acc[0][ct] = MFMA(a0, b, acc[0][ct]); acc[1][ct] = MFMA(a1, b, acc[1][ct]); }
      }
    }
    __syncthreads();
    if (kt + 1 < nk) { gemm_store(g, (u16*)smem); __syncthreads(); }
  }
}

DI void phase1(const Params& p) {
  const int tid = otid(), w = tid >> 6, lane = tid & 63, r = lane & 31, h = lane >> 5, wm = w >> 1, wn = w & 1;
  const u16* H = (const u16*)((const char*)p.out + YO_H);
  const u16* WinT = (const u16*)(p.ws + OFF_WINT); const u16* WmemT = (const u16*)(p.ws + OFF_WMEMT); const u16* MEMN = (const u16*)(p.ws + OFF_MEMN);
  u16* QKV = (u16*)(p.ws + OFF_QKV); u16* ZA = (u16*)(p.ws + OFF_ZA); u16* QB = (u16*)(p.ws + OFF_QB); u16* KB = (u16*)(p.ws + OFF_KB);
  u16* ZB = (u16*)(p.ws + OFF_ZB); u16* QC = (u16*)(p.ws + OFF_QC); u16* ZC = (u16*)(p.ws + OFF_ZC); u16* VBT = (u16*)(p.ws + OFF_VBT);
  u16* MEMK = (u16*)(p.ws + OFF_MEMK); u16* MEMVT = (u16*)(p.ws + OFF_MEMVT);
  u16* HALO = (u16*)((char*)p.out + YO_HALO);
  __shared__ int s_t1;
  int steal1 = 0; const unsigned xcc1 = xcc_id();
  while (true) {
    __syncthreads();
    if (otid() == 0) {
      int code = -1;
      while (steal1 < 8) {
        const unsigned x = (xcc1 + steal1) & 7u;
        const int per = 516 * (x < 4 ? 4 : 3) + 8;
        const int q = (int)atomicAdd((unsigned*)(p.ws + OFF_CTR) + 16 + x, 1u);
        if (q < per) { code = (int)x * 4096 + q; break; }
        ++steal1;
      }
      s_t1 = code;
    }
    __syncthreads();
    const int tq = __builtin_amdgcn_readfirstlane(s_t1);
    if (tq < 0) break;
    const int xq = tq >> 12, jq = tq & 4095;
    const int nown = xq < 4 ? 4 : 3, ngemm = 516 * nown;
    const int t = jq < ngemm ? 0 : 516 * 28 + xq * 8 + (jq - ngemm);
    f32x16 acc[2][4];
#pragma unroll
    for (int a = 0; a < 2; ++a)
#pragma unroll
      for (int b = 0; b < 4; ++b) acc[a][b] = zero16();
    if (t < 516 * 28) {
      const int mt = jq / nown, nt = xq + 8 * (jq % nown), m0 = mt * 128, n0 = nt * 256;
      const u16* a0 = H + (size_t)m0 * 1024;
      int grp; int cb;
      if (n0 < 3072) { grp = 0; cb = n0; } else if (n0 < 4096) { grp = 1; cb = n0 - 3072; } else { grp = 2 + (n0 - 4096) / 512; cb = (n0 - 4096) % 512; }
      const bool samp = m0 >= NP;
      if (grp == 4) {
        gemm_core<false>(a0, 1024, a0, 1024, a0, 1024, 1000, 1000, WinT + (size_t)n0 * 1024, 1024, 16, acc);
#pragma unroll
        for (int rt = 0; rt < 2; ++rt)
#pragma unroll
          for (int ct = 0; ct < 4; ++ct) {
            const int col = cb + wn * 128 + ct * 32 + r;
            const int rowb = m0 + wm * 64 + rt * 32 + 4 * h;
            const int hh = col >> 7, dv = col & 127;
#pragma unroll
            for (int q = 0; q < 4; ++q) {
              const int row = rowb + 8 * q;
              float v0 = acc[rt][ct][4 * q], v1 = acc[rt][ct][4 * q + 1], v2 = acc[rt][ct][4 * q + 2], v3 = acc[rt][ct][4 * q + 3];
              uint2 pk; pk.x = pk2(v0, v1); pk.y = pk2(v2, v3);
              if (!samp) {
                float* o = (p.out + O_VP) + (unsigned)(row * 512 + col); o[0] = v0; o[512] = v1; o[1024] = v2; o[1536] = v3;
                const int b = row >> 13, tt = row & 8191;
                *(uint2*)(VBT + (unsigned)(((b * 4 + hh) * 128 + dv) * 8192 + swap23(tt))) = pk;
              } else {
                const int rs = row - NP; float* o = (p.out + O_VS) + (unsigned)(rs * 512 + col); o[0] = v0; o[512] = v1; o[1024] = v2; o[1536] = v3;
                const int b = rs >> 5, tt = rs & 31;
                *(uint2*)((VBT + VBT_S_EL) + (unsigned)(((b * 4 + hh) * 128 + dv) * 32 + swap23(tt))) = pk;
              }
            }
          }
      } else {
        gemm_core<true>(a0, 1024, a0, 1024, a0, 1024, 1000, 1000, WinT + (size_t)n0 * 1024, 1024, 16, acc);
        u16* dst; unsigned ldd;
        switch (grp) {
          case 0: dst = QKV; ldd = 3072; break;
          case 1: dst = ZA; ldd = 1024; break;
          case 2: dst = QB; ldd = 512; break;
          case 3: dst = KB; ldd = 512; break;
          case 5: dst = ZB; ldd = 512; break;
          case 6: dst = QC; ldd = 512; break;
          default: dst = ZC; ldd = 512; break;
        }
#pragma unroll
        for (int rt = 0; rt < 2; ++rt) {
          const int row = m0 + wm * 64 + rt * 32 + r;
          int halo_row = -1, conv_row = -1;
          if (grp == 0) {
            if (!samp) {
              const int b = row >> 13, tt = row & 8191, tm = tt & 63;
              if (tm >= 61) halo_row = (b * 128 + (tt >> 6)) * 3 + tm - 61;
              if (tt >= 8189) conv_row = b * 3 + tt - 8189;
            } else {
              const int rs = row - NP, b = rs >> 5, ts = rs & 31;
              if (ts >= 29) conv_row = b * 3 + ts - 29;
            }
          }
          float* convp = p.out + (samp ? O_CS : O_CP);
          float* kout = samp ? (p.out + O_KS) + (unsigned)((row - NP) * 512) : (p.out + O_KP) + (unsigned)(row * 512);
#pragma unroll
          for (int ct = 0; ct < 4; ++ct)
#pragma unroll
            for (int q = 0; q < 4; ++q) {
              const int col = cb + wn * 128 + ct * 32 + 8 * q + 4 * h;
              const float v0 = acc[rt][ct][4 * q], v1 = acc[rt][ct][4 * q + 1], v2 = acc[rt][ct][4 * q + 2], v3 = acc[rt][ct][4 * q + 3];
              const uint2 pk = make_uint2(pk2(v0, v1), pk2(v2, v3));
              *(uint2*)(dst + (unsigned)row * ldd + col) = pk;
              if (grp == 0) {
                if (halo_row >= 0) *(uint2*)(HALO + (unsigned)(halo_row * 3072 + col)) = pk;
                if (conv_row >= 0) *(float4*)(convp + (unsigned)(conv_row * 3072 + col)) = make_float4(v0, v1, v2, v3);
              } else if (grp == 3) {
                *(float4*)(kout + col) = make_float4(v0, v1, v2, v3);
              }
            }
        }
      }
    } else {
      const int u = t - 516 * 28, mt = u / 4, nt = u % 4, m0 = mt * 128, n0 = nt * 256;
      const u16* a0 = MEMN + (size_t)m0 * 1024;
      if (n0 < 512) {
        gemm_core<true>(a0, 1024, a0, 1024, a0, 1024, 1000, 1000, WmemT + (size_t)n0 * 1024, 1024, 16, acc);
#pragma unroll
        for (int rt = 0; rt < 2; ++rt) {
          const int row = m0 + wm * 64 + rt * 32 + r;
#pragma unroll
          for (int ct = 0; ct < 4; ++ct)
#pragma unroll
            for (int q = 0; q < 4; ++q) {
              const int col = n0 + wn * 128 + ct * 32 + 8 * q + 4 * h;
              const float v0 = acc[rt][ct][4 * q], v1 = acc[rt][ct][4 * q + 1], v2 = acc[rt][ct][4 * q + 2], v3 = acc[rt][ct][4 * q + 3];
              *(float4*)((p.out + O_MK) + (unsigned)(row * 512 + col)) = make_float4(v0, v1, v2, v3);
              *(uint2*)(MEMK + (unsigned)(row * 512 + col)) = make_uint2(pk2(v0, v1), pk2(v2, v3));
            }
        }
      } else {
        gemm_core<false>(a0, 1024, a0, 1024, a0, 1024, 1000, 1000, WmemT + (size_t)n0 * 1024, 1024, 16, acc);
#pragma unroll
        for (int rt = 0; rt < 2; ++rt)
#pragma unroll
          for (int ct = 0; ct < 4; ++ct) {
            const int col = n0 + wn * 128 + ct * 32 + r;
            const int rowb = m0 + wm * 64 + rt * 32 + 4 * h;
            const int c2 = col - 512, hh = c2 >> 7, dv = c2 & 127;
#pragma unroll
            for (int q = 0; q < 4; ++q) {
              const int row = rowb + 8 * q;
              float v0 = acc[rt][ct][4 * q], v1 = acc[rt][ct][4 * q + 1], v2 = acc[rt][ct][4 * q + 2], v3 = acc[rt][ct][4 * q + 3];
              float* o = (p.out + O_MV) + (unsigned)(row * 512 + c2); o[0] = v0; o[512] = v1; o[1024] = v2; o[1536] = v3;
              uint2 pk; pk.x = pk2(v0, v1); pk.y = pk2(v2, v3);
              const int b = row >> 8, key = row & 255;
              *(uint2*)(MEMVT + (unsigned)(((b * 4 + hh) * 128 + dv) * 256 + swap23(key))) = pk;
            }
          }
      }
    }
  }
}

constexpr int KS_LD = 136, VT_LD = 72;

DI void stage_bf16(const u16* Kp, unsigned ldk, const u16* VTp, unsigned ldv, int nkeys) {
  u16* Ks = (u16*)smem; u16* Vt = Ks + 64 * KS_LD;
  const int tid = otid();
#pragma unroll
  for (int i = 0; i < 4; ++i) { int c = tid + 256 * i, row = c >> 4, ch = c & 15; if (row < nkeys) *(uint4*)(Ks + row * KS_LD + ch * 8) = *(const uint4*)(Kp + row * ldk + ch * 8); }
  for (int i = 0; i < 4; ++i) {
    int c = tid + 256 * i, row = c >> 3, ch = c & 7;
    if (ch * 8 < nkeys) *(uint4*)(Vt + row * VT_LD + ch * 8) = *(const uint4*)(VTp + row * ldv + ch * 8);
  }
}
DI void stage_f32(const float* Kp, unsigned ldk, const float* Vp, unsigned ldv) {
  u16* Ks = (u16*)smem; u16* Vt = Ks + 64 * KS_LD;
  const int tid = otid();
  for (int i = 0; i < 8; ++i) {
    int c = tid + 256 * i, row = c >> 5, ch = c & 31;
    float4 v = *(const float4*)(Kp + row * ldk + ch * 4);
    *(uint2*)(Ks + row * KS_LD + ch * 4) = make_uint2(pk2(v.x, v.y), pk2(v.z, v.w));
  }
  for (int i = 0; i < 4; ++i) {
    int u = tid + 256 * i; int q = (u & 7) + 8 * ((u >> 6) & 3), pp = ((u >> 3) & 7) + 8 * (u >> 8);
    float4 v0 = *(const float4*)(Vp + (unsigned)(2 * pp) * ldv + q * 4);
    float4 v1 = *(const float4*)(Vp + (unsigned)(2 * pp + 1) * ldv + q * 4);
    *(unsigned*)(Vt + (q * 4 + 0) * VT_LD + swap23(2 * pp)) = pk2(v0.x, v1.x);
    *(unsigned*)(Vt + (q * 4 + 1) * VT_LD + swap23(2 * pp)) = pk2(v0.y, v1.y);
    *(unsigned*)(Vt + (q * 4 + 2) * VT_LD + swap23(2 * pp)) = pk2(v0.z, v1.z);
    *(unsigned*)(Vt + (q * 4 + 3) * VT_LD + swap23(2 * pp)) = pk2(v0.w, v1.w);
  }
}

template <int NM, int KS, int NKT>
struct AttnSt { f32x16 O[NM][4]; float m[NM], l[NM]; bf16x8 qf[NM][KS]; };

template <int NM, int KS, int NKT>
DI void attn_init(AttnSt<NM, KS, NKT>& st, const u16* qrow  , int h, bool loadq = true) {
#pragma unroll
  for (int mm = 0; mm < NM; ++mm) {
#pragma unroll
    for (int d = 0; d < 4; ++d) st.O[mm][d] = zero16();
    st.m[mm] = -1e30f; st.l[mm] = 0.f;
#pragma unroll
    for (int ks = 0; ks < KS; ++ks) if (loadq) st.qf[mm][ks] = *(const bf16x8*)(qrow + mm * 64 + ks * 16 + h * 8);
  }
}

template <int NM, int KS, int NKT>
DI void attn_step(AttnSt<NM, KS, NKT>& st, const u16* Ks, int half, int dbase, float sc  ) {
  const u16* Vt = Ks + 64 * KS_LD;
  const int lane = otid() & 63, r = lane & 31, h = lane >> 5;
#pragma unroll
  for (int mm = 0; mm < NM; ++mm) {
    f32x16 s[NKT];
#pragma unroll
    for (int T = 0; T < NKT; ++T) {
      const int k0 = (NKT == 2 ? T : half) * 32;
      s[T] = zero16();
#pragma unroll
      for (int ks = 0; ks < KS; ++ks) {
        bf16x8 a = *(const bf16x8*)(Ks + (k0 + r) * KS_LD + dbase + mm * 64 + ks * 16 + h * 8);
        s[T] = MFMA(a, st.qf[mm][ks], s[T]);
      }
    }
    float mx = -1e30f;
#pragma unroll
    for (int T = 0; T < NKT; ++T)
#pragma unroll
      for (int i = 0; i < 16; ++i) mx = fmaxf(mx, s[T][i]);
    mx = fmaxf(mx, __shfl_xor(mx, 32));
    const float mxs = mx * sc;
    if (__builtin_amdgcn_ballot_w64(mxs > st.m[mm] + 8.f) != 0) {
      const float mnew = fmaxf(st.m[mm], mxs);
      const float alpha = __builtin_amdgcn_exp2f(st.m[mm] - mnew);
      st.m[mm] = mnew;
      st.l[mm] *= alpha;
#pragma unroll
      for (int d = 0; d < 4; ++d)
#pragma unroll
        for (int i = 0; i < 16; ++i) st.O[mm][d][i] *= alpha;
    }
    const float mref = st.m[mm];
    float rs = 0.f;
#pragma unroll
    for (int T = 0; T < NKT; ++T)
#pragma unroll
      for (int i = 0; i < 16; ++i) { float pv = __builtin_amdgcn_exp2f(s[T][i] * sc - mref); s[T][i] = pv; rs += pv; }
    st.l[mm] += rs;
#pragma unroll
    for (int T = 0; T < NKT; ++T) {
      const int k0 = (NKT == 2 ? T : half) * 32;
#pragma unroll
      for (int t = 0; t < 2; ++t) {
        if (NM > 1) asm volatile("" ::: "memory");
        bf16x8 pb = pack8(s[T], t);
#pragma unroll
        for (int d = 0; d < 4; ++d) {
          bf16x8 a = *(const bf16x8*)(Vt + (d * 32 + r) * VT_LD + k0 + 16 * t + 8 * h);
          st.O[mm][d] = MFMA(a, pb, st.O[mm][d]);
        }
      }
    }
  }
}

struct KVRegs { u32x4 k0, k1, k2, k3, v0, v1, v2, v3; };
DI void kv_load(KVRegs& g, const u16* Kp, unsigned ldk, const u16* VTp, unsigned ldv) {
  const int tid = otid();
  const int krow = tid >> 4, kch = tid & 15, vrow = tid >> 3, vch = tid & 7;
  const u16* pk = Kp + (unsigned)(krow * ldk + kch * 8);
  g.k0 = *(const u32x4*)pk; g.k1 = *(const u32x4*)(pk + 16 * ldk); g.k2 = *(const u32x4*)(pk + 32 * ldk); g.k3 = *(const u32x4*)(pk + 48 * ldk);
  const u16* pv = VTp + (unsigned)(vrow * ldv + vch * 8);
  g.v0 = *(const u32x4*)pv; g.v1 = *(const u32x4*)(pv + 32 * ldv); g.v2 = *(const u32x4*)(pv + 64 * ldv); g.v3 = *(const u32x4*)(pv + 96 * ldv);
}
DI void kv_store(const KVRegs& g, u16* Ks) {
  const int tid = otid();
  const int krow = tid >> 4, kch = tid & 15, vrow = tid >> 3, vch = tid & 7;
  u16* pk = Ks + krow * KS_LD + kch * 8;
  *(u32x4*)pk = g.k0; *(u32x4*)(pk + 16 * KS_LD) = g.k1; *(u32x4*)(pk + 32 * KS_LD) = g.k2; *(u32x4*)(pk + 48 * KS_LD) = g.k3;
  u16* pv = Ks + 64 * KS_LD + vrow * VT_LD + vch * 8;
  *(u32x4*)pv = g.v0; *(u32x4*)(pv + 32 * VT_LD) = g.v1; *(u32x4*)(pv + 64 * VT_LD) = g.v2; *(u32x4*)(pv + 96 * VT_LD) = g.v3;
}
constexpr int KVBUF = 64 * KS_LD + 128 * VT_LD;

DI float lam_value(const Params& p) {
  float s0 = 0.f, s1 = 0.f;
#pragma unroll 1
  for (int i = 0; i < 64; ++i) { s0 += p.lam_vec[i] * p.lam_vec[64 + i]; s1 += p.lam_vec[128 + i] * p.lam_vec[192 + i]; }
  return __expf(s0) - __expf(s1) + 0.2f;
}

DI void epi_diff(const Params& p, f32x16 (&o)[4], unsigned tok, int hh, int h) {
  float ss = 0.f;
#pragma unroll
  for (int d = 0; d < 4; ++d)
#pragma unroll
    for (int i = 0; i < 16; ++i) ss += o[d][i] * o[d][i];
  ss += __shfl_xor(ss, 32);
  const float rstd = rsqrtf(ss * (1.f / 128.f) + EPSF) * 0.8f;
  const u16* ZB = (const u16*)(p.ws + OFF_ZB); u16* MIXB = (u16*)(p.ws + OFF_QB);
#pragma unroll
  for (int d = 0; d < 4; ++d)
#pragma unroll
    for (int q = 0; q < 4; ++q) {
      if ((q & 1) == 0) asm volatile("" ::: "memory");
      const int dv = d * 32 + 8 * q + 4 * h;
      const uint2 zz = *(const uint2*)(ZB + tok * 512 + hh * 128 + dv);
      const float4 gg = *(const float4*)(p.g_sub + dv);
      float v0 = o[d][4 * q] * rstd * gg.x * silu(bflo(zz.x)), v1 = o[d][4 * q + 1] * rstd * gg.y * silu(bfhi(zz.x));
      float v2 = o[d][4 * q + 2] * rstd * gg.z * silu(bflo(zz.y)), v3 = o[d][4 * q + 3] * rstd * gg.w * silu(bfhi(zz.y));
      *(uint2*)(MIXB + tok * 512 + hh * 128 + dv) = make_uint2(pk2(v0, v1), pk2(v2, v3));
    }
}
DI void epi_mem(const Params& p, f32x16 (&o)[4], unsigned tok, int hh, int h) {
  const u16* ZC = (const u16*)(p.ws + OFF_ZC); u16* MIXC = (u16*)(p.ws + OFF_QC);
#pragma unroll
  for (int d = 0; d < 4; ++d)
#pragma unroll
    for (int q = 0; q < 4; ++q) {
      if ((q & 1) == 0) asm volatile("" ::: "memory");
      const int dv = d * 32 + 8 * q + 4 * h;
      const uint2 zz = *(const uint2*)(ZC + tok * 512 + hh * 128 + dv);
      float v0 = o[d][4 * q] * silu(bflo(zz.x)), v1 = o[d][4 * q + 1] * silu(bfhi(zz.x));
      float v2 = o[d][4 * q + 2] * silu(bflo(zz.y)), v3 = o[d][4 * q + 3] * silu(bfhi(zz.y));
      *(uint2*)(MIXC + tok * 512 + hh * 128 + dv) = make_uint2(pk2(v0, v1), pk2(v2, v3));
    }
}

constexpr float LOG2E = 1.4426950408889634f;

DI void attn_b_prompt(const Params& p, int bh, int c) {
  const int tid = otid(), w = tid >> 6, lane = tid & 63, r = lane & 31, h = lane >> 5;
  const int b = bh >> 2, hh = bh & 3, map = w >> 1, qsub = w & 1;
  const u16* QB = (const u16*)(p.ws + OFF_QB); const u16* KB = (const u16*)(p.ws + OFF_KB); const u16* VBT = (const u16*)(p.ws + OFF_VBT);
  const unsigned tok = (unsigned)b * 8192 + c * 64 + qsub * 32 + r;
  AttnSt<1, 4, 2> st;
  attn_init(st, QB + tok * 512 + hh * 128 + map * 64, h);
  const int ntiles = c + 1;
  const float sc = 0.125f * LOG2E;
  const u16* Kbase = KB + ((size_t)b * 8192) * 512 + hh * 128; const u16* VTbase = VBT + ((size_t)(b * 4 + hh) * 128) * 8192;
  KVRegs g;
  kv_load(g, Kbase, 512, VTbase, 8192);
  __syncthreads();
  kv_store(g, (u16*)smem);
  __syncthreads();
  for (int kt = 0; kt < ntiles; ++kt) {
    if (kt + 1 < ntiles) kv_load(g, Kbase + (unsigned)((kt + 1) * 64 * 512), 512, VTbase + (kt + 1) * 64, 8192);
    attn_step<1, 4, 2>(st, (const u16*)smem + (kt & 1) * KVBUF, 0, map * 64, sc);
    if (kt + 1 < ntiles) kv_store(g, (u16*)smem + ((kt + 1) & 1) * KVBUF);
    __syncthreads();
  }
  const float lam = lam_value(p);
  const float l = st.l[0] + __shfl_xor(st.l[0], 32);
  const float inv = (map == 0 ? 1.f : lam) / l;
#pragma unroll
  for (int d = 0; d < 4; ++d)
#pragma unroll
    for (int i = 0; i < 16; ++i) st.O[0][d][i] *= inv;
  float* slot = (float*)smem + qsub * 4096;
  if (map == 1) {
#pragma unroll
    for (int d = 0; d < 4; ++d)
#pragma unroll
      for (int i = 0; i < 16; ++i) slot[(d * 16 + i) * 64 + lane] = st.O[0][d][i];
  }
  __syncthreads();
  if (map == 0) {
#pragma unroll
    for (int d = 0; d < 4; ++d)
#pragma unroll
      for (int i = 0; i < 16; ++i) st.O[0][d][i] -= slot[(d * 16 + i) * 64 + lane];
    epi_diff(p, st.O[0], tok, hh, h);
  }
  __syncthreads();
}

DI void attn_step2q(AttnSt<2, 4, 2>& st, const u16* Ks, const u16* Qs, float sc) {
  const u16* Vt = Ks + 64 * KS_LD;
  const int tid = otid(), lane = tid & 63, r = lane & 31, h = lane >> 5, wq = tid >> 6;
#pragma unroll
  for (int T = 0; T < 2; ++T) {
    asm volatile("" ::: "memory");
    f32x16 s[2];
#pragma unroll
    for (int mm = 0; mm < 2; ++mm) {
      s[mm] = zero16();
#pragma unroll
      for (int ks = 0; ks < 4; ++ks) {
        bf16x8 a = *(const bf16x8*)(Ks + (T * 32 + r) * KS_LD + mm * 64 + ks * 16 + h * 8);
        bf16x8 q = *(const bf16x8*)(Qs + (wq * 32 + r) * 136 + mm * 64 + ks * 16 + h * 8);
        s[mm] = MFMA(a, q, s[mm]);
      }
    }
#pragma unroll
    for (int mm = 0; mm < 2; ++mm) {
      float mx = -1e30f;
#pragma unroll
      for (int i = 0; i < 16; ++i) mx = fmaxf(mx, s[mm][i]);
      mx = fmaxf(mx, __shfl_xor(mx, 32));
      const float mxs = mx * sc;
      if (__builtin_amdgcn_ballot_w64(mxs > st.m[mm] + 8.f) != 0) {
        const float mnew = fmaxf(st.m[mm], mxs);
        const float alpha = __builtin_amdgcn_exp2f(st.m[mm] - mnew);
        st.m[mm] = mnew; st.l[mm] *= alpha;
#pragma unroll
        for (int d = 0; d < 4; ++d)
#pragma unroll
          for (int i = 0; i < 16; ++i) st.O[mm][d][i] *= alpha;
      }
      const float mref = st.m[mm];
      float rs = 0.f;
#pragma unroll
      for (int i = 0; i < 16; ++i) { float pv = __builtin_amdgcn_exp2f(s[mm][i] * sc - mref); s[mm][i] = pv; rs += pv; }
      st.l[mm] += rs;
    }
#pragma unroll
    for (int t = 0; t < 2; ++t) {
      asm volatile("" ::: "memory");
      const bf16x8 pb0 = pack8(s[0], t), pb1 = pack8(s[1], t);
#pragma unroll
      for (int d = 0; d < 4; ++d) {
        bf16x8 a = *(const bf16x8*)(Vt + (d * 32 + r) * VT_LD + T * 32 + 16 * t + 8 * h);
        st.O[0][d] = MFMA(a, pb0, st.O[0][d]);
        st.O[1][d] = MFMA(a, pb1, st.O[1][d]);
      }
    }
  }
}
DI void attn_b_prompt2(const Params& p, int bh, int j) {
  const int b = bh >> 2, hh = bh & 3;
  const u16* QB = (const u16*)(p.ws + OFF_QB); const u16* KB = (const u16*)(p.ws + OFF_KB); const u16* VBT = (const u16*)(p.ws + OFF_VBT);
  AttnSt<2, 4, 2> st;
  attn_init(st, QB, 0, false);
  const int ntiles = 2 * j + 2;
  const float sc = 0.125f * LOG2E;
  const u16* Kbase = KB + ((size_t)b * 8192) * 512 + hh * 128; const u16* VTbase = VBT + ((size_t)(b * 4 + hh) * 128) * 8192;
  u16* Qs = (u16*)smem + KVBUF;
  KVRegs g;
  kv_load(g, Kbase, 512, VTbase, 8192);
  __syncthreads();
  {
    const int tid = otid();
    const u16* qsrc = QB + ((unsigned)b * 8192 + j * 128) * 512 + hh * 128;
#pragma unroll
    for (int i = 0; i < 8; ++i) { const int c = tid + 256 * i, row = c >> 4, ch = c & 15; *(uint4*)(Qs + row * 136 + ch * 8) = *(const uint4*)(qsrc + (unsigned)row * 512 + ch * 8); }
  }
  kv_store(g, (u16*)smem);
  __syncthreads();
  for (int kt = 0; kt < ntiles; ++kt) {
    if (kt + 1 < ntiles) kv_load(g, Kbase + (unsigned)((kt + 1) * 64 * 512), 512, VTbase + (kt + 1) * 64, 8192);
    if (kt < ntiles - 1 || (otid() >> 6) >= 2) attn_step2q(st, (const u16*)smem, Qs, sc);
    __syncthreads();
    if (kt + 1 < ntiles) { kv_store(g, (u16*)smem); __syncthreads(); }
  }
  const float lam = lam_value(p);
  const float l0 = st.l[0] + __shfl_xor(st.l[0], 32), l1 = st.l[1] + __shfl_xor(st.l[1], 32);
  const float i0 = 1.f / l0, i1 = lam / l1;
#pragma unroll
  for (int d = 0; d < 4; ++d)
#pragma unroll
    for (int i = 0; i < 16; ++i) st.O[0][d][i] = st.O[0][d][i] * i0 - st.O[1][d][i] * i1;
  const int tid = otid(), w = tid >> 6, lane = tid & 63, r = lane & 31, h = lane >> 5;
  const unsigned tok = (unsigned)b * 8192 + j * 128 + w * 32 + r;
  epi_diff(p, st.O[0], tok, hh, h);
}

DI void attn_c_prompt(const Params& p, int qt, int hh) {
  const int tid = otid(), w = tid >> 6, lane = tid & 63, r = lane & 31, h = lane >> 5;
  const u16* QC = (const u16*)(p.ws + OFF_QC); const u16* MEMK = (const u16*)(p.ws + OFF_MEMK); const u16* MEMVT = (const u16*)(p.ws + OFF_MEMVT);
  const unsigned tok = (unsigned)qt * 128 + w * 32 + r;
  const int b = qt >> 6;
  AttnSt<1, 8, 2> st;
  attn_init(st, QC + tok * 512 + hh * 128, h);
  const float sc = 0.08838834764831845f * LOG2E;
  const u16* Kbase = MEMK + ((size_t)b * 256) * 512 + hh * 128; const u16* VTbase = MEMVT + ((size_t)(b * 4 + hh) * 128) * 256;
  KVRegs g;
  kv_load(g, Kbase, 512, VTbase, 256);
  __syncthreads();
  kv_store(g, (u16*)smem);
  __syncthreads();
  for (int kt = 0; kt < 4; ++kt) {
    if (kt + 1 < 4) kv_load(g, Kbase + (unsigned)((kt + 1) * 64 * 512), 512, VTbase + (kt + 1) * 64, 256);
    attn_step<1, 8, 2>(st, (const u16*)smem + (kt & 1) * KVBUF, 0, 0, sc);
    if (kt + 1 < 4) kv_store(g, (u16*)smem + ((kt + 1) & 1) * KVBUF);
    __syncthreads();
  }
  float l0 = st.l[0] + __shfl_xor(st.l[0], 32);
  const float i0 = 1.f / l0;
#pragma unroll
  for (int d = 0; d < 4; ++d)
#pragma unroll
    for (int i = 0; i < 16; ++i) st.O[0][d][i] *= i0;
  epi_mem(p, st.O[0], tok, hh, h);
}

template <bool DIFF>
DI void attn_sample(const Params& p, int b, int hh) {
  const int tid = otid(), w = tid >> 6, lane = tid & 63, r = lane & 31, h = lane >> 5;
  const int map = w >> 1, half = w & 1;
  const bool active = DIFF || map == 0;
  const unsigned tok = (unsigned)NP + b * 32 + r;
  constexpr int KSN = DIFF ? 4 : 8;
  AttnSt<1, KSN, 1> st;
  const u16* Q = (const u16*)(p.ws + (DIFF ? OFF_QB : OFF_QC));
  attn_init(st, Q + tok * 512 + hh * 128 + (DIFF ? map * 64 : 0), h);
  const float sc = (DIFF ? 0.125f : 0.08838834764831845f) * LOG2E;
  const int dbase = DIFF ? map * 64 : 0;
  const int ncache = DIFF ? 64 : 4;
  const float* Kc = DIFF ? p.cache_diff_k : p.cache_mem_k; const float* Vc = DIFF ? p.cache_diff_v : p.cache_mem_v;
  const size_t T = DIFF ? 4096 : 256;
  for (int kt = 0; kt < ncache; ++kt) {
    __syncthreads();
    stage_f32(Kc + ((size_t)b * T + kt * 64) * 512 + hh * 128, 512, Vc + ((size_t)b * T + kt * 64) * 512 + hh * 128, 512);
    __syncthreads();
    if (active) attn_step<1, KSN, 1>(st, (const u16*)smem, half, dbase, sc);
  }
  if (DIFF) {
    const u16* KB = (const u16*)(p.ws + OFF_KB); const u16* VBT = (const u16*)(p.ws + OFF_VBT);
    __syncthreads();
    stage_bf16(KB + ((size_t)NP + b * 32) * 512 + hh * 128, 512, VBT + VBT_S_EL + ((size_t)(b * 4 + hh) * 128) * 32, 32, 32);
    __syncthreads();
    if (half == 0) attn_step<1, KSN, 1>(st, (const u16*)smem, 0, dbase, sc);
  }
  float* slot = (float*)smem + map * (64 * 64 + 128);
  __syncthreads();
  if (active && half == 1) {
#pragma unroll
    for (int d = 0; d < 4; ++d)
#pragma unroll
      for (int i = 0; i < 16; ++i) slot[(d * 16 + i) * 64 + lane] = st.O[0][d][i];
    slot[4096 + lane] = st.m[0]; slot[4160 + lane] = st.l[0];
  }
  __syncthreads();
  if (active && half == 0) {
    const float m2 = slot[4096 + lane], l2 = slot[4160 + lane];
    const float mn = fmaxf(st.m[0], m2), a1 = exp2f(st.m[0] - mn), a2 = exp2f(m2 - mn);
    float l = st.l[0] * a1 + l2 * a2;
    l += __shfl_xor(l, 32);
    const float inv = 1.f / l;
#pragma unroll
    for (int d = 0; d < 4; ++d)
#pragma unroll
      for (int i = 0; i < 16; ++i) st.O[0][d][i] = (st.O[0][d][i] * a1 + slot[(d * 16 + i) * 64 + lane] * a2) * inv;
  }
  __syncthreads();
  if (DIFF) {
    float* s0 = (float*)smem;
    if (w == 2) {
#pragma unroll
      for (int d = 0; d < 4; ++d)
#pragma unroll
        for (int i = 0; i < 16; ++i) s0[(d * 16 + i) * 64 + lane] = st.O[0][d][i];
    }
    __syncthreads();
    if (w == 0) {
      const float lam = lam_value(p);
#pragma unroll
      for (int d = 0; d < 4; ++d)
#pragma unroll
        for (int i = 0; i < 16; ++i) st.O[0][d][i] -= lam * s0[(d * 16 + i) * 64 + lane];
      epi_diff(p, st.O[0], tok, hh, h);
    }
  } else {
    if (w == 0) epi_mem(p, st.O[0], tok, hh, h);
  }
  __syncthreads();
}

DI size_t wbuf_off(int task) { return task < 8192 ? (size_t)task * 8192 : (size_t)8192 * 8192 + (size_t)(task - 8192) * 4096; }
DI size_t att_off(int task) { return task < 8192 ? (size_t)task * 4096 : (size_t)8192 * 4096 + (size_t)(task - 8192) * 1024; }

template <int C>
DI void g1_task(const Params& p, int task) {
  constexpr bool SAMPLE = (C == 32);
  const int tid = otid(), w = tid >> 6, lane = tid & 63, r = lane & 31, h = lane >> 5;
  int b, n, hh;
  if (!SAMPLE) { hh = task & 7; n = (task >> 3) & 127; b = task >> 10; } else { int u = task - 8192; hh = u & 7; b = u >> 3; n = 0; }
  const unsigned tok0 = SAMPLE ? (unsigned)NP + b * 32 : (unsigned)b * 8192 + n * 64;
  u16* qs = (u16*)smem; u16* ks = qs + 64 * 136; u16* raw = ks + 64 * 136;
  float* Lf = (float*)smem;
  float* fG = (float*)(smem + 51968); float* fB = fG + 64; float* fE = fB + 64;
  u16* QKV = (u16*)(p.ws + OFF_QKV);
  const u16* HALO = (const u16*)((const char*)p.out + YO_HALO);
  u16* WBUF = (u16*)((char*)p.out + YO_W); u16* ATT = (u16*)((char*)p.out + YO_ATT);
  const float* BA = (const float*)(p.ws + OFF_BA); float* GL = (float*)(p.ws + OFF_GL);

  float* fD = fE + 64;
  float* cw = (float*)(smem + 52736 + 256);
  if (w == 0) {
    float g = 0.f, beta = 0.f;
    if (lane < C) {
      const float bb = BA[(tok0 + lane) * 16 + hh], aa = BA[(tok0 + lane) * 16 + 8 + hh];
      beta = 1.f / (1.f + __expf(-bb));
      const float xx = aa + p.dt_bias[hh];
      const float sp = xx > 20.f ? xx : log1pf(__expf(xx));
      g = -__expf(p.a_log[hh]) * sp;
    }
    for (int d = 1; d < 64; d <<= 1) { float t = __shfl_up(g, d); if (lane >= d) g += t; }
    const float glast = __shfl(g, C - 1);
    if (lane < C) { fG[lane] = g; fB[lane] = beta; fE[lane] = __expf(g); fD[lane] = __expf(glast - g); }
  }
  for (int idx = tid; idx < 384; idx += 256) {
    const int rw_ = idx >> 5, c4 = idx & 31, sec = rw_ >> 2, tap = rw_ & 3;
    *(float4*)(cw + rw_ * 128 + c4 * 4) = *(const float4*)(p.conv_w + (unsigned)(tap * 3072 + sec * 1024 + hh * 128 + c4 * 4));
  }
  __syncthreads();
  const int crow_ = tid >> 2, cq = tid & 3;
  if (crow_ < C) {
#pragma unroll 1
    for (int sec = 0; sec < 3; ++sec) {
      const int colg = sec * 1024 + hh * 128;
      float y[32]; float ss = 0.f;
#pragma unroll
      for (int c8 = 0; c8 < 4; ++c8) {
        const int col = cq * 32 + c8 * 8;
        uint4 xv[4];
#pragma unroll
        for (int i = 0; i < 4; ++i) {
          const int rr = crow_ + i;
          if (rr >= 3) xv[i] = *(const uint4*)(QKV + (tok0 + rr - 3) * 3072 + colg + col);
          else if (SAMPLE) {
            const float* cc = p.cache_conv + ((size_t)b * 3 + rr) * 3072 + colg + col;
            const float4 a = *(const float4*)cc, bq = *(const float4*)(cc + 4);
            xv[i] = make_uint4(pk2(a.x, a.y), pk2(a.z, a.w), pk2(bq.x, bq.y), pk2(bq.z, bq.w));
          } else if (n == 0) xv[i] = make_uint4(0, 0, 0, 0);
          else xv[i] = *(const uint4*)(HALO + ((size_t)((b * 128 + n - 1) * 3 + rr)) * 3072 + colg + col);
        }
        float acc8[8];
#pragma unroll
        for (int e = 0; e < 8; ++e) acc8[e] = 0.f;
#pragma unroll
        for (int i = 0; i < 4; ++i) {
          const float4 w0 = *(const float4*)(cw + (sec * 4 + i) * 128 + col), w1 = *(const float4*)(cw + (sec * 4 + i) * 128 + col + 4);
          acc8[0] += bflo(xv[i].x) * w0.x; acc8[1] += bfhi(xv[i].x) * w0.y; acc8[2] += bflo(xv[i].y) * w0.z; acc8[3] += bfhi(xv[i].y) * w0.w;
          acc8[4] += bflo(xv[i].z) * w1.x; acc8[5] += bfhi(xv[i].z) * w1.y; acc8[6] += bflo(xv[i].w) * w1.z; acc8[7] += bfhi(xv[i].w) * w1.w;
        }
#pragma unroll
        for (int e = 0; e < 8; ++e) { float v = silu(acc8[e]); y[c8 * 8 + e] = v; ss += v * v; }
      }
      float sc = 1.f;
      if (sec < 2) {
        ss += __shfl_xor(ss, 1); ss += __shfl_xor(ss, 2);
        sc = rsqrtf(ss + EPSF) * (sec == 0 ? 0.08838834764831845f : 1.f);
      }
      u16* dst = sec == 0 ? qs + crow_ * 136 + cq * 32 : (sec == 1 ? ks + crow_ * 136 + cq * 32 : raw + crow_ * 128 + cq * 32);
#pragma unroll
      for (int c8 = 0; c8 < 4; ++c8)
        *(uint4*)(dst + c8 * 8) = make_uint4(pk2(y[c8 * 8] * sc, y[c8 * 8 + 1] * sc), pk2(y[c8 * 8 + 2] * sc, y[c8 * 8 + 3] * sc), pk2(y[c8 * 8 + 4] * sc, y[c8 * 8 + 5] * sc), pk2(y[c8 * 8 + 6] * sc, y[c8 * 8 + 7] * sc));
    }
  }
  __syncthreads();
  const u16* vs = raw;
  const int ri = w >> 1, ci = w & 1;
  const bool act = SAMPLE ? (w == 0) : true;
  const bool lower = act && (ri >= ci);
  f32x16 kk = zero16(), qk = zero16();
  if (lower) {
#pragma unroll
    for (int s = 0; s < 8; ++s) {
      bf16x8 bk = *(const bf16x8*)(ks + (ci * 32 + r) * 136 + s * 16 + h * 8);
      bf16x8 ak = *(const bf16x8*)(ks + (ri * 32 + r) * 136 + s * 16 + h * 8);
      bf16x8 aq = *(const bf16x8*)(qs + (ri * 32 + r) * 136 + s * 16 + h * 8);
      kk = MFMA(ak, bk, kk); qk = MFMA(aq, bk, qk);
    }
  }
  __syncthreads();
  for (int idx = tid; idx < C * 16; idx += 256) {
    const int row = idx >> 4, ch = idx & 15;
    const uint4 v = *(const uint4*)(qs + row * 136 + ch * 8);
    const float e = fE[row];
    st16_wt(QKV + (tok0 + row) * 3072 + hh * 128 + ch * 8,
            make_uint4(pk2(bflo(v.x) * e, bfhi(v.x) * e), pk2(bflo(v.y) * e, bfhi(v.y) * e), pk2(bflo(v.z) * e, bfhi(v.z) * e), pk2(bflo(v.w) * e, bfhi(v.w) * e)));
  }
  {
    const float gl = fG[C - 1];
    for (int idx = tid; idx < 16 * C; idx += 256) {
      const int dk = idx & 127, c0 = (idx >> 7) * 8;
      float v[8];
#pragma unroll
      for (int j = 0; j < 8; ++j) v[j] = bf2f(ks[(c0 + j) * 136 + dk]) * fD[c0 + j];
      const int flat = dk * C + c0;
      const uint4 ov = make_uint4(pk2(v[0], v[1]), pk2(v[2], v[3]), pk2(v[4], v[5]), pk2(v[6], v[7]));
      st16_wt(QKV + (tok0 + (flat >> 7)) * 3072 + 1024 + hh * 128 + (flat & 127), ov);
    }
    if (tid == 0) __hip_atomic_store((unsigned*)GL + task, __float_as_uint(__expf(gl)), __ATOMIC_RELAXED, __HIP_MEMORY_SCOPE_AGENT);
  }
  __syncthreads();
  float* LT = (float*)smem;
  if (act) {
    const int col = ci * 32 + r;
    const float gc = fG[col];
#pragma unroll
    for (int i = 0; i < 16; ++i) {
      const int row = ri * 32 + crow(i, h);
      const float dec = __expf(fminf(fG[row] - gc, 0.f));
      if (lower) LT[col * 68 + row] = row > col ? fB[row] * kk[i] * dec : 0.f;
      st2_wt(ATT + att_off(task) + row * C + col, f2bf(row >= col ? qk[i] * dec : 0.f));
    }
  }
  __syncthreads();
  {
    const int cc = tid & 127; const bool isU = tid < 128;
    u16* X = isU ? (raw + cc) : (ks + cc);
    const int ld = isU ? 128 : 136;
#pragma unroll 1
    for (int ib = 0; ib < C / 8; ++ib) {
      float a[8];
#pragma unroll
      for (int ii = 0; ii < 8; ++ii) { const int i = ib * 8 + ii; a[ii] = bf2f(X[i * ld]) * (isU ? fB[i] : fB[i] * fE[i]); }
#pragma unroll 2
      for (int j = 0; j < ib * 8; ++j) {
        const float xj = bf2f(X[j * ld]);
        const float4 l0 = *(const float4*)(LT + j * 68 + ib * 8), l1 = *(const float4*)(LT + j * 68 + ib * 8 + 4);
        a[0] -= l0.x * xj; a[1] -= l0.y * xj; a[2] -= l0.z * xj; a[3] -= l0.w * xj;
        a[4] -= l1.x * xj; a[5] -= l1.y * xj; a[6] -= l1.z * xj; a[7] -= l1.w * xj;
      }
#pragma unroll
      for (int ii = 1; ii < 8; ++ii)
#pragma unroll
        for (int jj = 0; jj < ii; ++jj) a[ii] -= LT[(ib * 8 + jj) * 68 + ib * 8 + ii] * a[jj];
#pragma unroll
      for (int ii = 0; ii < 8; ++ii) X[(ib * 8 + ii) * ld] = f2bf(a[ii]);
    }
  }
  __syncthreads();
  {
    u16* wd = WBUF + wbuf_off(task);
    for (int idx = tid; idx < C * 16; idx += 256) {
      const int row = idx >> 4, ch = idx & 15;
      st16_wt(QKV + (tok0 + row) * 3072 + 2048 + hh * 128 + ch * 8, *(const uint4*)(raw + row * 128 + ch * 8));
      st16_wt(wd + row * 128 + ch * 8, *(const uint4*)(ks + row * 136 + ch * 8));
    }
  }
  asm volatile("s_waitcnt vmcnt(0)" ::: "memory");
  __syncthreads();
  if (tid == 0) {
    unsigned* cnt = (unsigned*)(p.ws + OFF_CTR) + 64 + (SAMPLE ? 512 + b * 8 + hh : (b * 8 + hh) * 8 + (n >> 4));
    __hip_atomic_fetch_add(cnt, 1u, __ATOMIC_RELAXED, __HIP_MEMORY_SCOPE_AGENT);
  }
  __syncthreads();
}

template <int RT>
DI void scan_task(const Params& p, int b, int hh) {
  constexpr int C = 32 * RT; constexpr bool SAMPLE = (RT == 1);
  constexpr int NI = C / 16, NA = (C == 64) ? 2 : 1;
  const int tid = otid(), w = tid >> 6, lane = tid & 63, r = lane & 31, h = lane >> 5;
  u16* wsm = (u16*)smem; u16* us = wsm + 64 * 136; u16* qds = us + 64 * 136; u16* kts = qds + 64 * 136; u16* asm_ = kts + 128 * 72;
  u16* QKV = (u16*)(p.ws + OFF_QKV);
  const u16* WBUF = (const u16*)((const char*)p.out + YO_W); const u16* ATT = (const u16*)((const char*)p.out + YO_ATT);
  const float* GL = (const float*)(p.ws + OFF_GL);
  f32x16 S[4];
  if (SAMPLE) {
#pragma unroll
    for (int d = 0; d < 4; ++d)
#pragma unroll
      for (int i = 0; i < 16; ++i) {
        const float* srow = p.state_gdn + (size_t)(b * 8 + hh) * 128 * 128 + (d * 32 + (i & 3) + 8 * (i >> 2)) * 128;
        S[d][i] = srow[(unsigned)(4 * h * 128 + w * 32 + r)];
      }
  } else {
#pragma unroll
    for (int d = 0; d < 4; ++d) S[d] = zero16();
  }
  const int nchunks = SAMPLE ? 1 : 128;
  auto wait_group = [&](int grp) {
    if (otid() == 0) {
      unsigned* cnt = (unsigned*)(p.ws + OFF_CTR) + 64 + (SAMPLE ? 512 + b * 8 + hh : (b * 8 + hh) * 8 + grp);
      const unsigned need = SAMPLE ? 1u : 16u;
      while (__hip_atomic_load(cnt, __ATOMIC_RELAXED, __HIP_MEMORY_SCOPE_AGENT) < need) __builtin_amdgcn_s_sleep(16);
      __builtin_amdgcn_fence(__ATOMIC_ACQUIRE, "agent");
      asm volatile("s_waitcnt vmcnt(0)" ::: "memory");
    }
    __syncthreads();
  };
  wait_group(0);
  u32x4 rw[NI], ru[NI], rq[NI], rk[NI], ra[NA];
  auto task_of = [&](int n) { return SAMPLE ? 8192 + b * 8 + hh : (b * 128 + n) * 8 + hh; };
  auto tok_of = [&](int n) { return SAMPLE ? (unsigned)NP + b * 32 : (unsigned)b * 8192 + n * 64; };
#define SCAN_LOAD1(n_)                                                                                   \
  {                                                                                                      \
    const int tid = otid();                                                            \
    const u16* wsrc = WBUF + wbuf_off(task_of(n_)); const unsigned tk = tok_of(n_);                      \
    const unsigned lo_w = (unsigned)((tid >> 4) * 128 + (tid & 15) * 8), lo_q = (unsigned)((tid >> 4) * 3072 + (tid & 15) * 8); \
    _Pragma("unroll") for (int i = 0; i < NI; ++i) {                                                     \
      const u16* qb_ = QKV + (size_t)(tk + 16 * i) * 3072 + hh * 128;                         \
      rw[i] = *(const u32x4*)((wsrc + 16 * i * 128) + lo_w);                                             \
      ru[i] = *(const u32x4*)((qb_ + 2048) + lo_q);                                                      \
    }                                                                                                    \
  }
#define SCAN_STORE1()                                                                                    \
  {                                                                                                      \
    const int tid = otid();                                                            \
    _Pragma("unroll") for (int i = 0; i < NI; ++i) {                                                     \
      const int idx = tid + 256 * i, row = idx >> 4, ch = idx & 15;                                      \
      st_perm16(wsm + row * 136, ch, rw[i]); *(u32x4*)(us + row * 136 + ch * 8) = ru[i];                 \
    }                                                                                                    \
  }
#define SCAN_LOAD2(n_)                                                                                   \
  {                                                                                                      \
    const int tid = otid();                                                            \
    const u16* asrc = ATT + att_off(task_of(n_)); const unsigned tk = tok_of(n_);                        \
    const unsigned lo_k = (unsigned)((tid >> 4) * 3072 + (tid & 15) * 8);                                \
    _Pragma("unroll") for (int i = 0; i < NI; ++i) {                                                     \
      const u16* qb_ = QKV + (size_t)(tk + 16 * i) * 3072 + hh * 128;                         \
      rq[i] = *(const u32x4*)(qb_ + lo_k);                                                               \
      rk[i] = *(const u32x4*)((qb_ + 1024) + lo_k);                                                      \
    }                                                                                                    \
    _Pragma("unroll") for (int i = 0; i < NA; ++i) {                                                     \
      const int idx = tid + 256 * i;                                                                     \
      if (idx < C * C / 8) ra[i] = *(const u32x4*)(asrc + (idx / (C / 8)) * C + (idx % (C / 8)) * 8);    \
    }                                                                                                    \
  }
#define SCAN_STORE2()                                                                                    \
  {                                                                                                      \
    const int tid = otid();                                                            \
    _Pragma("unroll") for (int i = 0; i < NI; ++i) {                                                     \
      const int idx = tid + 256 * i, row = idx >> 4, ch = idx & 15;                                      \
      st_perm16(qds + row * 136, ch, rq[i]);                                                             \
      const int f8 = idx * 8;                                                                            \
      st_perm16(kts + (f8 / C) * 72, (f8 % C) >> 3, rk[i]);                                              \
    }                                                                                                    \
    _Pragma("unroll") for (int i = 0; i < NA; ++i) {                                                     \
      const int idx = tid + 256 * i;                                                                     \
      if (idx < C * C / 8) st_perm16(asm_ + (idx / (C / 8)) * 72, idx % (C / 8), ra[i]);                 \
    }                                                                                                    \
  }
  __syncthreads();
  SCAN_LOAD1(0); SCAN_LOAD2(0);
  SCAN_STORE1(); SCAN_STORE2();
  __syncthreads();
  for (int n = 0; n < nchunks; ++n) {
    const bool have_next = n + 1 < nchunks;
    const unsigned tok0 = tok_of(n);
    const int tid = otid(), w = tid >> 6, lane = tid & 63, r = lane & 31, h = lane >> 5;
    if (have_next && ((n + 1) & 15) == 0) wait_group((n + 1) >> 4);
    if (have_next) SCAN_LOAD1(n + 1);
    const float gl = __uint_as_float(__hip_atomic_load((const unsigned*)GL + task_of(n), __ATOMIC_RELAXED, __HIP_MEMORY_SCOPE_AGENT));
    f32x16 e[RT];
#pragma unroll
    for (int rt = 0; rt < RT; ++rt)
#pragma unroll
      for (int i = 0; i < 16; ++i) e[rt][i] = -bf2f(us[(rt * 32 + crow(i, h)) * 136 + w * 32 + r]);
#pragma unroll
    for (int d = 0; d < 4; ++d)
#pragma unroll
      for (int t = 0; t < 2; ++t) {
        asm volatile("" ::: "memory");
        const bf16x8 sb = pack8(S[d], t);
#pragma unroll
        for (int rt = 0; rt < RT; ++rt) {
          bf16x8 aw = *(const bf16x8*)(wsm + (rt * 32 + r) * 136 + d * 32 + 16 * t + 8 * h);
          e[rt] = MFMA(aw, sb, e[rt]);
        }
      }
    __syncthreads();
    if (have_next) { SCAN_STORE1(); SCAN_LOAD2(n + 1); }
    bf16x8 ebf[RT][2];
#pragma unroll
    for (int rt = 0; rt < RT; ++rt) {
#pragma unroll
      for (int i = 0; i < 16; ++i) e[rt][i] = -e[rt][i];
      ebf[rt][0] = pack8(e[rt], 0); ebf[rt][1] = pack8(e[rt], 1);
    }
#pragma unroll 1
    for (int rt = 0; rt < RT; ++rt) {
      const int tid = otid(), w = tid >> 6, lane = tid & 63, r = lane & 31, h = lane >> 5;
      f32x16 o = zero16();
#pragma unroll
      for (int d = 0; d < 4; ++d)
#pragma unroll
        for (int t = 0; t < 2; ++t) {
          if (t == 0) asm volatile("" ::: "memory");
          bf16x8 aq = *(const bf16x8*)(qds + (rt * 32 + r) * 136 + d * 32 + 16 * t + 8 * h);
          o = MFMA(aq, pack8(S[d], t), o);
        }
#pragma unroll
      for (int jt = 0; jt < RT; ++jt)
#pragma unroll
        for (int t = 0; t < 2; ++t) {
          if (t == 0) asm volatile("" ::: "memory");
          bf16x8 aa = *(const bf16x8*)(asm_ + (rt * 32 + r) * 72 + jt * 32 + 16 * t + 8 * h);
          o = MFMA(aa, ebf[jt][t], o);
        }
#pragma unroll
      for (int i = 0; i < 16; ++i) {
        u16* orow = QKV + (size_t)(tok0 + rt * 32 + (i & 3) + 8 * (i >> 2)) * 3072 + 2048 + hh * 128;
        orow[(unsigned)(4 * h * 3072 + w * 32 + r)] = f2bf(o[i]);
      }
    }
    const int tid3 = otid(), lane3 = tid3 & 63, r3 = lane3 & 31, h3 = lane3 >> 5;
#pragma unroll
    for (int d = 0; d < 4; ++d)
#pragma unroll
      for (int i = 0; i < 16; ++i) S[d][i] *= gl;
#pragma unroll
    for (int jt = 0; jt < RT; ++jt)
#pragma unroll
      for (int t = 0; t < 2; ++t) {
        asm volatile("" ::: "memory");
        const bf16x8 eb = ebf[jt][t];
#pragma unroll
        for (int d = 0; d < 4; ++d) {
          bf16x8 ak = *(const bf16x8*)(kts + (d * 32 + r3) * 72 + jt * 32 + 16 * t + 8 * h3);
          S[d] = MFMA(ak, eb, S[d]);
        }
      }
    __syncthreads();
    if (have_next) SCAN_STORE2();
    __syncthreads();
  }
#undef SCAN_LOAD1
#undef SCAN_STORE1
#undef SCAN_LOAD2
#undef SCAN_STORE2
  asm volatile("s_waitcnt vmcnt(0)" ::: "memory");
  __syncthreads();
  __builtin_amdgcn_fence(__ATOMIC_ACQUIRE, "agent");
  {
    const int tidf = otid(), l8 = tidf & 7;
    const int nrows = SAMPLE ? 32 : 8192; const unsigned tokb = SAMPLE ? (unsigned)NP + b * 32 : (unsigned)b * 8192;
    const u16* ZA = (const u16*)(p.ws + OFF_ZA);
    const float* gp = p.g_gdn + l8 * 16;
    for (int row = tidf >> 3; row < nrows; row += 32) {
      u16* op = QKV + (tokb + row) * 3072 + 2048 + hh * 128 + l8 * 16;
      const u16* zp = ZA + (tokb + row) * 1024 + hh * 128 + l8 * 16;
      const uint4 o0 = *(const uint4*)op, o1 = *(const uint4*)(op + 8);
      const uint4 z0 = *(const uint4*)zp, z1 = *(const uint4*)(zp + 8);
      float v[16] = {bflo(o0.x), bfhi(o0.x), bflo(o0.y), bfhi(o0.y), bflo(o0.z), bfhi(o0.z), bflo(o0.w), bfhi(o0.w),
                     bflo(o1.x), bfhi(o1.x), bflo(o1.y), bfhi(o1.y), bflo(o1.z), bfhi(o1.z), bflo(o1.w), bfhi(o1.w)};
      float zz[16] = {bflo(z0.x), bfhi(z0.x), bflo(z0.y), bfhi(z0.y), bflo(z0.z), bfhi(z0.z), bflo(z0.w), bfhi(z0.w),
                      bflo(z1.x), bfhi(z1.x), bflo(z1.y), bfhi(z1.y), bflo(z1.z), bfhi(z1.z), bflo(z1.w), bfhi(z1.w)};
      float ss = 0.f;
#pragma unroll
      for (int j = 0; j < 16; ++j) ss += v[j] * v[j];
      ss += __shfl_xor(ss, 1); ss += __shfl_xor(ss, 2); ss += __shfl_xor(ss, 4);
      const float rstd = rsqrtf(ss * (1.f / 128.f) + EPSF);
      unsigned ow[8];
#pragma unroll
      for (int j = 0; j < 8; ++j) ow[j] = pk2(v[2 * j] * rstd * gp[2 * j] * silu(zz[2 * j]), v[2 * j + 1] * rstd * gp[2 * j + 1] * silu(zz[2 * j + 1]));
      *(uint4*)op = make_uint4(ow[0], ow[1], ow[2], ow[3]);
      *(uint4*)(op + 8) = make_uint4(ow[4], ow[5], ow[6], ow[7]);
    }
  }
  float* so = p.out + (SAMPLE ? O_SS : O_SP) + (size_t)(b * 8 + hh) * 128 * 128;
#pragma unroll
  for (int d = 0; d < 4; ++d)
#pragma unroll
    for (int i = 0; i < 16; ++i) { float* srow = so + (d * 32 + (i & 3) + 8 * (i >> 2)) * 128; srow[(unsigned)(4 * h * 128 + w * 32 + r)] = S[d][i]; }
}

DI void phase2(const Params& p) {
  __shared__ int s_task;
  unsigned* ctr = (unsigned*)(p.ws + OFF_CTR);
  constexpr int NPRE = 192 + 128 + 8192 + 64, NPOST = 2048 + 64;
  int stage = 0, steal = 0; const unsigned xcc = xcc_id();
  while (true) {
    __syncthreads();
    if (otid() == 0) {
      int code = -1;
      if (stage == 0) { const int t = (int)atomicAdd(ctr, 1u); if (t < NPRE) code = t; else stage = 1; }
      if (stage == 1) { const int q = (int)atomicAdd(ctr + 8, 1u); if (q < 2048) code = NPRE + q; else stage = 2; }
      if (stage == 2) { const int t = (int)atomicAdd(ctr + 1, 1u); if (t < NPOST) code = NPRE + 4096 + t; }
      s_task = code;
    }
    __syncthreads();
    int t = __builtin_amdgcn_readfirstlane(s_task);
    if (t < 0) break;
#ifndef TM
#define TM 127
#endif
    if (t < 64) { if (TM & 64) scan_task<2>(p, t >> 3, t & 7); continue; }
    if (t < 192) { if (TM & 64) scan_task<1>(p, (t - 64) >> 3, (t - 64) & 7); continue; }
    t -= 192;
    if (t < 128) { if (TM & 8) g1_task<32>(p, 8192 + t); continue; }
    t -= 128;
    if (t < 8192) { if (TM & 4) { const int n = t >> 6, s = t & 63; g1_task<64>(p, ((s >> 3) * 128 + n) * 8 + (s & 7)); } continue; }
    t -= 8192;
    if (t < 64) { if (TM & 2) attn_sample<true>(p, t >> 2, t & 3); continue; }
    t -= 64;
    if (t < 4096) {
      if (TM & 1) { if (t < 2048) attn_b_prompt2(p, t & 31, 63 - (t >> 5)); }
      continue;
    }
    t -= 4096;
    if (t < 2048) { if (TM & 16) attn_c_prompt(p, t >> 2, t & 3); continue; }
    t -= 2048;
    if (TM & 32) attn_sample<false>(p, t >> 2, t & 3);
  }
}

DI void phase3b(const Params& p) {
  const int tid = otid(), w = tid >> 6, lane = tid & 63;
  u16* QKV = (u16*)(p.ws + OFF_QKV); const u16* ZA = (const u16*)(p.ws + OFF_ZA);
  for (int row = blockIdx.x * 4 + w; row < NT; row += gridDim.x * 4) {
    u16* op = QKV + (unsigned)row * 3072u + 2048 + lane * 16;
    const u16* zp = ZA + (unsigned)row * 1024u + lane * 16;
    const uint4 o0 = *(const uint4*)op, o1 = *(const uint4*)(op + 8);
    const uint4 z0 = *(const uint4*)zp, z1 = *(const uint4*)(zp + 8);
    float v[16] = {bflo(o0.x), bfhi(o0.x), bflo(o0.y), bfhi(o0.y), bflo(o0.z), bfhi(o0.z), bflo(o0.w), bfhi(o0.w),
                   bflo(o1.x), bfhi(o1.x), bflo(o1.y), bfhi(o1.y), bflo(o1.z), bfhi(o1.z), bflo(o1.w), bfhi(o1.w)};
    float zz[16] = {bflo(z0.x), bfhi(z0.x), bflo(z0.y), bfhi(z0.y), bflo(z0.z), bfhi(z0.z), bflo(z0.w), bfhi(z0.w),
                    bflo(z1.x), bfhi(z1.x), bflo(z1.y), bfhi(z1.y), bflo(z1.z), bfhi(z1.z), bflo(z1.w), bfhi(z1.w)};
    float ss = 0.f;
#pragma unroll
    for (int j = 0; j < 16; ++j) ss += v[j] * v[j];
    ss += __shfl_xor(ss, 1); ss += __shfl_xor(ss, 2); ss += __shfl_xor(ss, 4);
    const float rstd = rsqrtf(ss * (1.f / 128.f) + EPSF);
    const float* gp = p.g_gdn + (lane & 7) * 16;
    unsigned ow[8];
#pragma unroll
    for (int j = 0; j < 8; ++j) ow[j] = pk2(v[2 * j] * rstd * gp[2 * j] * silu(zz[2 * j]), v[2 * j + 1] * rstd * gp[2 * j + 1] * silu(zz[2 * j + 1]));
    *(uint4*)op = make_uint4(ow[0], ow[1], ow[2], ow[3]);
    *(uint4*)(op + 8) = make_uint4(ow[4], ow[5], ow[6], ow[7]);
  }
}

DI void phase4(const Params& p) {
  const int tid = otid(), w = tid >> 6, lane = tid & 63, r = lane & 31, h = lane >> 5, wm = w >> 1, wn = w & 1;
  const u16* QKV = (const u16*)(p.ws + OFF_QKV); const u16* MIXB = (const u16*)(p.ws + OFF_QB); const u16* MIXC = (const u16*)(p.ws + OFF_QC);
  const u16* WoutT = (const u16*)(p.ws + OFF_WOUTT);
  __shared__ int s_t4;
  int steal4 = 0; const unsigned xcc4 = xcc_id();
  while (true) {
    __syncthreads();
    if (otid() == 0) s_t4 = xq_fetch((unsigned*)(p.ws + OFF_CTR) + 24, 258, xcc4, steal4);
    __syncthreads();
    const int tq = __builtin_amdgcn_readfirstlane(s_t4);
    if (tq < 0) break;
    const int xq = tq / 258, jq = tq % 258;
    const int nt = xq & 3, mt = jq * 2 + (xq >> 2), m0 = mt * 128, n0 = nt * 256;
    f32x16 acc[2][4];
#pragma unroll
    for (int a = 0; a < 2; ++a)
#pragma unroll
      for (int b = 0; b < 4; ++b) acc[a][b] = zero16();
    gemm_core<true>(QKV + (size_t)m0 * 3072 + 2048, 3072, MIXB + (size_t)m0 * 512, 512, MIXC + (size_t)m0 * 512, 512, 16, 24, WoutT + (size_t)n0 * 2048, 2048, 32, acc);
#pragma unroll
    for (int rt = 0; rt < 2; ++rt) {
      const int row = m0 + wm * 64 + rt * 32 + r;
      const float* xr = row < NP ? p.x_prompt + (unsigned)(row * 1024) : p.x_sample + (unsigned)((row - NP) * 1024);
      float* yr = p.out + (unsigned)(row * 1024);
#pragma unroll
      for (int ct = 0; ct < 4; ++ct)
#pragma unroll
        for (int q = 0; q < 4; ++q) {
          const int col = n0 + wn * 128 + ct * 32 + 8 * q + 4 * h;
          const float4 xv = *(const float4*)(xr + col);
          st16_wt(yr + col, make_uint4(__float_as_uint(xv.x + acc[rt][ct][4 * q]), __float_as_uint(xv.y + acc[rt][ct][4 * q + 1]), __float_as_uint(xv.z + acc[rt][ct][4 * q + 2]), __float_as_uint(xv.w + acc[rt][ct][4 * q + 3])));
        }
    }
    asm volatile("s_waitcnt vmcnt(0)" ::: "memory");
    __syncthreads();
    if (otid() == 0) {
      const unsigned old = __hip_atomic_fetch_add((unsigned*)(p.ws + OFF_CTR) + 1024 + mt, 1u, __ATOMIC_RELAXED, __HIP_MEMORY_SCOPE_AGENT);
      s_t4 = (old == 3u) ? 1 : 0;
    }
    __syncthreads();
    if (__builtin_amdgcn_readfirstlane(s_t4)) {
      __builtin_amdgcn_fence(__ATOMIC_ACQUIRE, "agent");
      asm volatile("s_waitcnt vmcnt(0)" ::: "memory");
      const int tid2 = otid(), w2 = tid2 >> 6, lane2 = tid2 & 63;
#pragma unroll 2
      for (int rr = 0; rr < 32; ++rr) {
        float* y = p.out + (unsigned)((m0 + w2 * 32 + rr) * 1024);
        float4 xv[4]; float ss = 0.f;
#pragma unroll
        for (int i = 0; i < 4; ++i) { xv[i] = *(const float4*)(y + i * 256 + lane2 * 4); ss += xv[i].x * xv[i].x + xv[i].y * xv[i].y + xv[i].z * xv[i].z + xv[i].w * xv[i].w; }
        ss = wave_sum(ss);
        const float rstd = rsqrtf(ss * (1.f / 1024.f) + EPSF);
#pragma unroll
        for (int i = 0; i < 4; ++i) {
          const float4 gv = *(const float4*)(p.g_final + i * 256 + lane2 * 4);
          xv[i].x *= rstd * gv.x; xv[i].y *= rstd * gv.y; xv[i].z *= rstd * gv.z; xv[i].w *= rstd * gv.w;
          *(float4*)(y + i * 256 + lane2 * 4) = xv[i];
        }
      }
    }
  }
}

DI void phase5(const Params& p) {
  const int tid = otid(), w = tid >> 6, lane = tid & 63;
  for (int row = blockIdx.x * 4 + w; row < NT; row += gridDim.x * 4) {
    float* y = p.out + (size_t)row * 1024;
    float4 xv[4]; float ss = 0.f;
#pragma unroll
    for (int i = 0; i < 4; ++i) { xv[i] = *(const float4*)(y + i * 256 + lane * 4); ss += xv[i].x * xv[i].x + xv[i].y * xv[i].y + xv[i].z * xv[i].z + xv[i].w * xv[i].w; }
    ss = wave_sum(ss);
    const float rstd = rsqrtf(ss * (1.f / 1024.f) + EPSF);
#pragma unroll
    for (int i = 0; i < 4; ++i) {
      float4 gv = *(const float4*)(p.g_final + i * 256 + lane * 4);
      xv[i].x *= rstd * gv.x; xv[i].y *= rstd * gv.y; xv[i].z *= rstd * gv.z; xv[i].w *= rstd * gv.w;
      *(float4*)(y + i * 256 + lane * 4) = xv[i];
    }
  }
}

__global__ void __launch_bounds__(256, 2) mega(Params p, int ph_lo, int ph_hi) {
  cg::grid_group grid = cg::this_grid();
#ifndef PM
#define PM 63
#endif
  if (ph_lo <= 0 && ph_hi >= 0) { if (PM & 1) phase0(p); }
  if (ph_lo <= 0 && ph_hi >= 1) grid.sync();
  if (ph_lo <= 1 && ph_hi >= 1) { if (PM & 2) phase1(p); }
  if (ph_lo <= 1 && ph_hi >= 2) grid.sync();
  if (ph_lo <= 2 && ph_hi >= 2) { if (PM & 4) phase2(p); }
  if (ph_lo <= 2 && ph_hi >= 4) grid.sync();
  if (ph_lo <= 4 && ph_hi >= 4) { if (PM & 16) phase4(p); }
}

extern "C" void kernel_launch(void* const* d_in, const int* in_sizes, int n_in, void* d_out, int out_size, void* d_ws, size_t ws_size, hipStream_t stream) {
  static int grid_blocks = 0;
  if (!grid_blocks) {
    int dev = 0, cus = 0, per_cu = 0;
    hipGetDevice(&dev);
    hipDeviceGetAttribute(&cus, hipDeviceAttributeMultiprocessorCount, dev);
    hipOccupancyMaxActiveBlocksPerMultiprocessor(&per_cu, mega, 256, 0);
    if (per_cu < 1) per_cu = 1;
    if (per_cu > 2) per_cu = 2;
    grid_blocks = cus * per_cu;
  }
  Params p{};
  p.x_prompt = (const float*)d_in[0]; p.x_sample = (const float*)d_in[1]; p.mem_prompt = (const float*)d_in[2];
  p.cache_diff_k = (const float*)d_in[3]; p.cache_diff_v = (const float*)d_in[4]; p.cache_mem_k = (const float*)d_in[5]; p.cache_mem_v = (const float*)d_in[6];
  p.state_gdn = (const float*)d_in[7]; p.cache_conv = (const float*)d_in[8]; p.g_pre = (const float*)d_in[9]; p.w_in = (const float*)d_in[10];
  p.conv_w = (const float*)d_in[11]; p.a_log = (const float*)d_in[12]; p.dt_bias = (const float*)d_in[13]; p.g_gdn = (const float*)d_in[14];
  p.lam_vec = (const float*)d_in[15]; p.g_sub = (const float*)d_in[16]; p.g_mem = (const float*)d_in[17]; p.w_mem_kv = (const float*)d_in[18];
  p.w_out = (const float*)d_in[19]; p.g_final = (const float*)d_in[20];
  p.out = (float*)d_out; p.ws = (char*)d_ws;
  hipMemsetAsync((char*)d_ws + OFF_CTR, 0, 8192, stream);
#if ONE_LAUNCH
  int lo = 0, hi = 5;
  void* args[] = {&p, &lo, &hi};
  hipError_t e = hipLaunchCooperativeKernel((void*)mega, dim3(grid_blocks), dim3(256), args, 0, stream);
  if (e != hipSuccess) fprintf(stderr, "cooperative launch failed: %s (grid %d)\n", hipGetErrorString(e), grid_blocks);
#else
  for (int ph = 0; ph <= 5; ++ph) hipLaunchKernelGGL(mega, dim3(grid_blocks), dim3(256), 0, stream, p, ph, ph);
#endif
}
```
